# Optimizing an MI355X kernel written in HIP

```python
import jax, jax.numpy as jnp
from jax import lax
import numpy as np

D_MODEL = 2048
BATCH = 4
SEQ = 8192
DEPTH = 2

GRID_W = 64
CTX_LEN = 256
MIX_WIDTH = D_MODEL
FOURIER_WIDTH = MIX_WIDTH // 2
LRU_WIDTH = MIX_WIDTH - FOURIER_WIDTH
FOURIER_GROUPS = 4
FOURIER_GROUP_DIM = FOURIER_WIDTH // FOURIER_GROUPS
LRU_HEADS = 4
LRU_HEAD_DIM = LRU_WIDTH // LRU_HEADS
CONV_WIDTH = 4
CONV_LEFT = 2
LRU_C = 8.0
FFN_MULT = 256
D_FF = ((8 * D_MODEL + 3 * FFN_MULT - 1) // (3 * FFN_MULT)) * FFN_MULT
IN_COLS = FOURIER_WIDTH + 2 * LRU_WIDTH
N_MOD = 6
N_NORMS = 4
EPS = 1e-6

kernel_name = "hybrid_fourier_rglru_dit_block"


def rms_norm(x, g):
    xf = x.astype(jnp.float32)
    y = xf * lax.rsqrt(jnp.mean(xf * xf, axis=-1, keepdims=True) + EPS)
    return (y * g.astype(jnp.float32)).astype(x.dtype)


def modulate(h, shift, scale):
    return h * (1 + scale) + shift


def fourier_grid(u, w_four):
    bsz, length, _ = u.shape
    rows = length // GRID_W
    uf = u.astype(jnp.float32).reshape(bsz, rows, GRID_W, FOURIER_GROUPS, FOURIER_GROUP_DIM)
    z = jnp.fft.fftn(uf, axes=(1, 2, 4), norm="ortho").real
    z = z.reshape(bsz, length, FOURIER_GROUPS, FOURIER_GROUP_DIM).astype(u.dtype)
    return jnp.einsum("blgi,gij->blgj", z, w_four).reshape(bsz, length, FOURIER_WIDTH)


def fourier_seq(u, w_four):
    bsz, length, _ = u.shape
    uf = u.astype(jnp.float32).reshape(bsz, length, FOURIER_GROUPS, FOURIER_GROUP_DIM)
    z = jnp.fft.fftn(uf, axes=(1, 3), norm="ortho").real.astype(u.dtype)
    return jnp.einsum("blgi,gij->blgj", z, w_four).reshape(bsz, length, FOURIER_WIDTH)


def centred_depthwise_conv(u, w_conv, b_conv):
    length = u.shape[1]
    up = jnp.pad(u, ((0, 0), (CONV_LEFT, CONV_WIDTH - 1 - CONV_LEFT), (0, 0)))
    out = b_conv
    for k in range(CONV_WIDTH):
        out = out + w_conv[k] * up[:, k:k + length]
    return out


def rglru_coeffs(u, w_gates, b_gates, lam):
    bsz, length, _ = u.shape
    uh = u.reshape(bsz, length, LRU_HEADS, LRU_HEAD_DIM)
    gates = jnp.einsum("blhi,ghij->gblhj", uh, w_gates).reshape(2, bsz, length, LRU_WIDTH)
    gates = gates.astype(jnp.float32) + b_gates[:, None, None, :].astype(jnp.float32)
    r = jax.nn.sigmoid(gates[0])
    i = jax.nn.sigmoid(gates[1])
    log_a = -LRU_C * r * jax.nn.softplus(-lam.astype(jnp.float32))
    a = jnp.exp(log_a)
    x_in = jnp.sqrt(-jnp.expm1(2.0 * log_a)) * (i * u.astype(jnp.float32))
    return a, x_in


def _affine_combine(e1, e2):
    a1, b1 = e1
    a2, b2 = e2
    return a1 * a2, a2 * b1 + b2


def linear_scan(a, bx, h0):
    bx = bx.at[:, 0].add(a[:, 0] * h0)
    _, h = lax.associative_scan(_affine_combine, (a, bx), axis=1)
    return h


def mixing_sublayer(h_lat, h_ctx, w_in, w_four, conv_w, conv_b, lru_w, lru_b, lru_lam, w_out, with_ctx_out):
    split_at = (FOURIER_WIDTH, FOURIER_WIDTH + LRU_WIDTH)
    f_lat, r_lat, g_lat = jnp.split(h_lat @ w_in, split_at, axis=-1)
    f_ctx, r_ctx, g_ctx = jnp.split(h_ctx @ w_in, split_at, axis=-1)
    r_lat = centred_depthwise_conv(r_lat, conv_w, conv_b)
    r_ctx = centred_depthwise_conv(r_ctx, conv_w, conv_b)
    rec_lat, rec_ctx = [], []
    for d in range(2):
        a_c, b_c = rglru_coeffs(r_ctx, lru_w[d], lru_b[d], lru_lam[d])
        a_l, b_l = rglru_coeffs(r_lat, lru_w[d], lru_b[d], lru_lam[d])
        if d == 1:
            a_c, b_c, a_l, b_l = (jnp.flip(t, axis=1) for t in (a_c, b_c, a_l, b_l))
        h_c = linear_scan(a_c, b_c, jnp.zeros_like(a_c[:, 0]))
        h_l = linear_scan(a_l, b_l, h_c[:, -1])
        if d == 1:
            h_c, h_l = jnp.flip(h_c, axis=1), jnp.flip(h_l, axis=1)
        rec_lat.append(h_l)
        rec_ctx.append(h_c)
    rec_l = (rec_lat[0] + rec_lat[1]).astype(h_lat.dtype)
    y_lat = jnp.concatenate([fourier_grid(f_lat, w_four), jax.nn.gelu(g_lat) * rec_l], axis=-1) @ w_out
    if not with_ctx_out:
        return y_lat, None
    rec_c = (rec_ctx[0] + rec_ctx[1]).astype(h_ctx.dtype)
    y_ctx = jnp.concatenate([fourier_seq(f_ctx, w_four), jax.nn.gelu(g_ctx) * rec_c], axis=-1) @ w_out
    return y_lat, y_ctx


def swiglu(h, w_ffn_in, w_ffn_out):
    g, u = jnp.split(h @ w_ffn_in, 2, axis=-1)
    return (jax.nn.silu(g) * u) @ w_ffn_out


def setup_inputs(seed: int = 0) -> dict:
    key = jax.random.key(seed)
    ks = jax.random.split(key, 17)
    f32 = jnp.float32
    x = jax.random.normal(ks[0], (BATCH, SEQ, D_MODEL), f32)
    c = jax.random.normal(ks[1], (BATCH, D_MODEL), f32)
    ctx = jax.random.normal(ks[2], (BATCH, CTX_LEN, D_MODEL), f32)
    c_ctx = jax.random.normal(ks[3], (D_MODEL,), f32)
    w_ada = jax.random.normal(ks[4], (DEPTH, D_MODEL, N_MOD * D_MODEL), f32) * (0.5 * D_MODEL ** -0.5)
    b_ada = 0.02 * jax.random.normal(ks[5], (DEPTH, N_MOD * D_MODEL), f32)
    norm_g = 1.0 + 0.01 * jax.random.normal(ks[6], (DEPTH, N_NORMS, D_MODEL), f32)
    w_in = jax.random.normal(ks[7], (DEPTH, D_MODEL, IN_COLS), f32) * D_MODEL ** -0.5
    w_four = jax.random.normal(ks[8], (DEPTH, FOURIER_GROUPS, FOURIER_GROUP_DIM, FOURIER_GROUP_DIM), f32) * FOURIER_GROUP_DIM ** -0.5
    conv_w = jax.random.normal(ks[9], (DEPTH, CONV_WIDTH, LRU_WIDTH), f32) * CONV_WIDTH ** -0.5
    conv_b = 0.01 * jax.random.normal(ks[10], (DEPTH, LRU_WIDTH), f32)
    lru_w = jax.random.normal(ks[11], (DEPTH, 2, 2, LRU_HEADS, LRU_HEAD_DIM, LRU_HEAD_DIM), f32) * LRU_HEAD_DIM ** -0.5
    lru_b = 0.01 * jax.random.normal(ks[12], (DEPTH, 2, 2, LRU_WIDTH), f32)
    a_c = jax.random.uniform(ks[13], (DEPTH, 2, LRU_WIDTH), f32, minval=0.9, maxval=0.999)
    s = a_c ** (1.0 / LRU_C)
    lru_lam = jnp.log(s) - jnp.log1p(-s)
    w_out = jax.random.normal(ks[14], (DEPTH, MIX_WIDTH, D_MODEL), f32) * MIX_WIDTH ** -0.5
    w_ffn_in = jax.random.normal(ks[15], (DEPTH, D_MODEL, 2 * D_FF), f32) * D_MODEL ** -0.5
    w_ffn_out = jax.random.normal(ks[16], (DEPTH, D_FF, D_MODEL), f32) * D_FF ** -0.5
    return {"x": x, "c": c, "ctx": ctx, "c_ctx": c_ctx, "w_ada": w_ada, "b_ada": b_ada,
            "norm_g": norm_g, "w_in": w_in, "w_four": w_four, "conv_w": conv_w, "conv_b": conv_b,
            "lru_w": lru_w, "lru_b": lru_b, "lru_lam": lru_lam, "w_out": w_out,
            "w_ffn_in": w_ffn_in, "w_ffn_out": w_ffn_out}


def reference(x, c, ctx, c_ctx, w_ada, b_ada, norm_g, w_in, w_four, conv_w, conv_b,
              lru_w, lru_b, lru_lam, w_out, w_ffn_in, w_ffn_out):
    mod_lat = jnp.einsum("bd,ldm->lbm", jax.nn.silu(c), w_ada) + b_ada[:, None, :]
    mod_ctx = jnp.einsum("d,ldm->lm", jax.nn.silu(c_ctx), w_ada) + b_ada
    for layer in range(DEPTH):
        last = layer == DEPTH - 1
        ml = jnp.split(mod_lat[layer][:, None, :], N_MOD, axis=-1)
        mc = jnp.split(mod_ctx[layer][None, None, :], N_MOD, axis=-1)
        g = norm_g[layer]
        h_lat = modulate(rms_norm(x, g[0]), ml[0], ml[1])
        h_ctx = modulate(rms_norm(ctx, g[0]), mc[0], mc[1])
        y_lat, y_ctx = mixing_sublayer(h_lat, h_ctx, w_in[layer], w_four[layer], conv_w[layer], conv_b[layer],
                                       lru_w[layer], lru_b[layer], lru_lam[layer], w_out[layer],
                                       not last)
        x = x + ml[2] * rms_norm(y_lat, g[1])
        f_lat = swiglu(modulate(rms_norm(x, g[2]), ml[3], ml[4]), w_ffn_in[layer], w_ffn_out[layer])
        x = x + ml[5] * rms_norm(f_lat, g[3])
        if not last:
            ctx = ctx + mc[2] * rms_norm(y_ctx, g[1])
            f_ctx = swiglu(modulate(rms_norm(ctx, g[2]), mc[3], mc[4]), w_ffn_in[layer], w_ffn_out[layer])
            ctx = ctx + mc[5] * rms_norm(f_ctx, g[3])
    return x
```

```cpp
#include <hip/hip_runtime.h>
#include <hip/hip_cooperative_groups.h>
#include <cstdio>
namespace cg = cooperative_groups;

#define LAS __attribute__((address_space(3)))
typedef unsigned short bf16_t;
typedef short bf16x8 __attribute__((ext_vector_type(8)));
typedef float f32x4 __attribute__((ext_vector_type(4)));
typedef unsigned u32x2 __attribute__((ext_vector_type(2)));
typedef float f32x2 __attribute__((ext_vector_type(2)));
typedef unsigned u32x4 __attribute__((ext_vector_type(4)));

constexpr int D = 2048, NB = 4, SEQ = 8192, CTXL = 256, DEPTH = 2;
constexpr int MLAT = NB * SEQ, MCTX = NB * CTXL, MALL = MLAT + MCTX;
constexpr int DFF = 5632, NCH = 264;
constexpr float EPS = 1e-6f, FX = 16777216.0f, FXI = 1.0f / 16777216.0f;

constexpr size_t AL(size_t x) { return (x + 255) & ~(size_t)255; }
constexpr size_t OFF_MOD = 0;
constexpr size_t OFF_RSS = OFF_MOD + (size_t)2 * 5 * 12288 * 4;
constexpr size_t OFF_BAR = OFF_RSS + (size_t)4 * MALL * 8;
constexpr size_t ZERO_BYTES = OFF_BAR + 3456 * 4;
constexpr size_t OFF_CST = AL(ZERO_BYTES);
constexpr size_t OFF_D2 = OFF_CST + 512 * 256 * 2;
constexpr size_t OFF_D3 = OFF_D2 + 256 * 256 * 2;
constexpr size_t OFF_DC = OFF_D3 + 256 * 512 * 2;
constexpr size_t OFF_SP8 = OFF_DC + 256 * 512 * 2;
constexpr size_t OFF_MODF = OFF_SP8 + 2 * 2 * 1024 * 4;
constexpr size_t OFF_W = OFF_MODF + (size_t)2 * 5 * 12288 * 4;
constexpr size_t W_WINT = 0;
constexpr size_t W_WINNAT = W_WINT + (size_t)4096 * 2048 * 2;
constexpr size_t W_WOUTT = W_WINNAT + (size_t)2048 * 1024 * 2;
constexpr size_t W_WOUTRAW = W_WOUTT + (size_t)2048 * 2048 * 2;
constexpr size_t W_WFNAT = W_WOUTRAW + (size_t)2048 * 1024 * 2;
constexpr size_t W_WGT = W_WFNAT + (size_t)4 * 256 * 256 * 2;
constexpr size_t W_WFFI = W_WGT + (size_t)4096 * 256 * 2;
constexpr size_t W_WFFO = W_WFFI + (size_t)11264 * 2048 * 2;
constexpr size_t W_LAYER = W_WFFO + (size_t)2048 * 5632 * 2;
constexpr size_t OFF_XC = OFF_W + 2 * W_LAYER;
constexpr size_t OFF_H = OFF_XC + (size_t)MCTX * D * 4;
constexpr size_t OFF_A = OFF_H + (size_t)MALL * D * 2;
constexpr size_t OFF_R = OFF_A + (size_t)MALL * D * 2;
constexpr size_t OFF_GG = OFF_R + (size_t)MALL * 1024 * 2;
constexpr size_t OFF_U = OFF_GG + (size_t)MALL * 1024 * 2;
constexpr size_t OFF_BX = OFF_U + (size_t)MALL * 1024 * 2;
constexpr size_t OFF_M2 = OFF_BX + (size_t)MALL * D * 2;
constexpr size_t OFF_SA = OFF_M2 + (size_t)MALL * D * 2;
constexpr size_t SZ_S = (size_t)NB * 2 * NCH * 1024 * 4;
constexpr size_t OFF_SH = OFF_SA + SZ_S;
constexpr size_t OFF_CARRY = OFF_SH + SZ_S;
constexpr size_t OFF_FS = OFF_CARRY + SZ_S;
constexpr size_t OFF_RSSP = OFF_FS + (size_t)4 * MCTX * D * 4;
constexpr size_t WS_END = OFF_RSSP + (size_t)MLAT * 32 * 4;
constexpr size_t OFF_ACT = OFF_A;
static_assert((size_t)MALL * DFF * 2 <= OFF_M2 - OFF_A, "ACT alias");

struct P {
  const float *x, *c, *ctx, *c_ctx, *w_ada, *b_ada, *norm_g, *w_in, *w_four, *conv_w, *conv_b, *lru_w, *lru_b, *lru_lam, *w_out, *w_ffn_in, *w_ffn_out;
  float* out; unsigned char* ws;
};

typedef const __attribute__((address_space(4))) P* KernArgP;
__device__ __forceinline__ P load_p() {
#if defined(__HIP_DEVICE_COMPILE__)
  KernArgP q = (KernArgP)__builtin_amdgcn_kernarg_segment_ptr(); asm volatile("" : "+s"(q));
  P r; r.x = q->x; r.c = q->c; r.ctx = q->ctx; r.c_ctx = q->c_ctx; r.w_ada = q->w_ada; r.b_ada = q->b_ada; r.norm_g = q->norm_g; r.w_in = q->w_in; r.w_four = q->w_four; r.conv_w = q->conv_w;
  r.conv_b = q->conv_b; r.lru_w = q->lru_w; r.lru_b = q->lru_b; r.lru_lam = q->lru_lam; r.w_out = q->w_out; r.w_ffn_in = q->w_ffn_in; r.w_ffn_out = q->w_ffn_out; r.out = q->out; r.ws = q->ws; return r;
#else
  return P{};
#endif
}

__device__ __forceinline__ unsigned cvt_pk_bf16(float lo, float hi) { unsigned r; asm volatile("v_cvt_pk_bf16_f32 %0, %1, %2" : "=v"(r) : "v"(lo), "v"(hi)); return r; }
__device__ __forceinline__ float bf_lo(unsigned w) { return __uint_as_float(w << 16); }
__device__ __forceinline__ float bf_hi(unsigned w) { return __uint_as_float(w & 0xffff0000u); }
__device__ __forceinline__ float wave_sum(float v) {
#pragma unroll
  for (int o = 32; o >= 1; o >>= 1) v += __shfl_xor(v, o);
  return v;
}
__device__ __forceinline__ float lane_xor(float v, int lane, int mask) { return __int_as_float(__builtin_amdgcn_ds_bpermute((lane ^ mask) << 2, __float_as_int(v))); }
__device__ __forceinline__ float wave_sum_l(float v, int lane) {
#pragma unroll
  for (int o = 32; o >= 1; o >>= 1) v += lane_xor(v, lane, o);
  return v;
}
__device__ __forceinline__ int tid_fresh(int wvid) { int t = wvid * 64 + (int)__builtin_amdgcn_mbcnt_hi(~0u, __builtin_amdgcn_mbcnt_lo(~0u, 0u)); asm volatile("" : "+v"(t)); return t; }
__device__ __forceinline__ float sigmoidf_(float v) { return __builtin_amdgcn_rcpf(1.0f + __builtin_amdgcn_exp2f(-1.4426950408889634f * v)); }
__device__ __forceinline__ f32x2 swiglu_pk(f32x2 g, f32x2 u) {
  const f32x2 t = g * -1.4426950408889634f; f32x2 e; e.x = __builtin_amdgcn_exp2f(t.x); e.y = __builtin_amdgcn_exp2f(t.y);
  const f32x2 d = e + 1.0f; f32x2 r; r.x = __builtin_amdgcn_rcpf(d.x); r.y = __builtin_amdgcn_rcpf(d.y);
  return (g * u) * r;
}
__device__ __forceinline__ f32x2 sigmoid_pk(f32x2 v) { const f32x2 t = v * -1.4426950408889634f; f32x2 e; e.x = __builtin_amdgcn_exp2f(t.x); e.y = __builtin_amdgcn_exp2f(t.y);
  const f32x2 d = e + 1.0f; f32x2 r; r.x = __builtin_amdgcn_rcpf(d.x); r.y = __builtin_amdgcn_rcpf(d.y); return r; }
__device__ __forceinline__ void gates_pk(f32x2 vr, f32x2 vi, f32x2 sp8, f32x2 u, f32x2& la, f32x2& bx) {
  const f32x2 rg = sigmoid_pk(vr), ig = sigmoid_pk(vi); la = -(rg * sp8);
  const f32x2 t = la * 2.8853900817779268f; f32x2 e; e.x = __builtin_amdgcn_exp2f(t.x); e.y = __builtin_amdgcn_exp2f(t.y);
  const f32x2 o = 1.0f - e; f32x2 q; q.x = __builtin_amdgcn_sqrtf(fmaxf(o.x, 0.f)); q.y = __builtin_amdgcn_sqrtf(fmaxf(o.y, 0.f));
  bx = q * (ig * u);
}
__device__ __forceinline__ float gelu_tanh(float v) { const float t = 0.7978845608028654f * (v + 0.044715f * v * v * v); return v * sigmoidf_(2.0f * t); }
__device__ __forceinline__ void st4bf(bf16_t* p, f32x4 v) { u32x2 w; w.x = cvt_pk_bf16(v[0], v[1]); w.y = cvt_pk_bf16(v[2], v[3]); *(u32x2*)p = w; }


#define XB_TMO      128
#define XB_XCNT(j)  (256  + 64 * (j))
#define XB_XSUB(j)  (1280 + 64 * (j))
#define XB_XGEN(j)  (2304 + 64 * (j))
#define XB_TOP      3328
#define XB_TOPGEN   3392
#define XB_SPIN_CAP (1u << 20)
__device__ __forceinline__ unsigned xb_ld(unsigned* p)              { return __hip_atomic_load(p, __ATOMIC_RELAXED, __HIP_MEMORY_SCOPE_AGENT); }
__device__ __forceinline__ unsigned xb_add(unsigned* p, unsigned v) { return __hip_atomic_fetch_add(p, v, __ATOMIC_RELAXED, __HIP_MEMORY_SCOPE_AGENT); }
__device__ __forceinline__ unsigned xb_xcc_id() { return (unsigned)__builtin_amdgcn_s_getreg((3 << 11) | 20) & 0xFu; }
#define XB_SPIN(cond, bar) do { unsigned _sp = 0; while (cond) { __builtin_amdgcn_s_sleep(1); \
    if ((++_sp & 255u) == 0u) { if (xb_ld(&(bar)[XB_TMO])) break; if (_sp > XB_SPIN_CAP) { atomicAdd(&(bar)[XB_TMO], 1u); break; } } } } while (0)
struct XcdBarrier { unsigned* bar; unsigned x; volatile LAS unsigned* st; };
__device__ __forceinline__ XcdBarrier xcd_barrier_post(unsigned* bar, volatile LAS unsigned* st, int tid) {
  XcdBarrier b; b.bar = bar; b.x = 0u; b.st = st;
  if (tid == 0) { const unsigned x = xb_xcc_id(); st[2] = x; (void)xb_add(&bar[XB_XCNT(x)], 1u); }
  return b;
}
__device__ __forceinline__ void xcd_barrier_complete(unsigned* bar, unsigned x, unsigned& nloc, unsigned& nx) {
  const unsigned G = gridDim.x * gridDim.y * gridDim.z;
  unsigned sum, cnt, mine, sp = 0u;
  for (;;) {
    sum = 0u; cnt = 0u; mine = 0u;
#pragma unroll
    for (unsigned j = 0; j < 16; ++j) { const unsigned c = xb_ld(&bar[XB_XCNT(j)]); sum += c; cnt += (c > 0u) ? 1u : 0u; mine = (j == x) ? c : mine; }
    if (sum == G) break;
    __builtin_amdgcn_s_sleep(1);
    if ((++sp & 255u) == 0u) { if (xb_ld(&bar[XB_TMO])) break; if (sp > XB_SPIN_CAP) { atomicAdd(&bar[XB_TMO], 1u); break; } }
  }
  nloc = mine > 0u ? mine : 1u; nx = cnt > 0u ? cnt : 1u;
}
__device__ __forceinline__ void xcd_barrier(const XcdBarrier& b, int tid) {
  asm volatile("s_waitcnt vmcnt(0)" ::: "memory");
  __syncthreads();
  if (tid == 0) {
    unsigned* bar = b.bar;
    __builtin_amdgcn_s_waitcnt(0);
    unsigned nloc = b.st[0], nx = b.st[1]; const unsigned bx = __builtin_amdgcn_readfirstlane(b.st[2]);
    if (nloc == 0u) { xcd_barrier_complete(bar, bx, nloc, nx); b.st[0] = nloc; b.st[1] = nx; }
    const unsigned old = xb_add(&bar[XB_XSUB(bx)], 1u);
    const unsigned gen = old / nloc;
    if (old + 1u == (gen + 1u) * nloc) {
      __builtin_amdgcn_fence(__ATOMIC_RELEASE, "agent");
      asm volatile("s_waitcnt vmcnt(0)" ::: "memory");
      const unsigned og = xb_add(&bar[XB_TOP], 1u);
      const unsigned tg = og / nx;
      if (og + 1u == (tg + 1u) * nx) xb_add(&bar[XB_TOPGEN], 1u);
      else XB_SPIN(xb_ld(&bar[XB_TOPGEN]) == tg, bar);
      __builtin_amdgcn_fence(__ATOMIC_ACQUIRE, "agent");
      xb_add(&bar[XB_XGEN(bx)], 1u);
      asm volatile("s_waitcnt vmcnt(0)" ::: "memory");
    } else {
      XB_SPIN(xb_ld(&bar[XB_XGEN(bx)]) == gen, bar);
      __builtin_amdgcn_fence(__ATOMIC_ACQUIRE, "agent");
      asm volatile("s_waitcnt vmcnt(0)" ::: "memory");
    }
  }
  __syncthreads();
}

constexpr int BM = 256, BK = 64, HALF = 128, HTB = HALF * BK * 2, STAGE_BYTES = 8 * HTB, NXCD = 8, WGM = 8;
__device__ __forceinline__ int lds_byte(int r, int c) { const int st = (r >> 4) * 2 + (c >> 5), rr = r & 15, cc = c & 31, ob = rr * 64 + cc * 2; return st * 1024 + (ob ^ (((ob >> 9) & 1) << 5)); }
__device__ __forceinline__ void stage_rc(int b, int& R, int& C) { const int st = b / 1024, sb = b % 1024, swz = sb ^ (((sb >> 9) & 1) << 5); R = (st >> 1) * 16 + swz / 64; C = (st & 1) * 32 + (swz % 64) / 2; }

__device__ __forceinline__ int perm32(int rho) { const int n = rho >> 4, i = rho & 15; return 8 * (i >> 2) + 4 * n + (i & 3); }
struct Unit { int pm, pn; const char* a; const char* b; size_t o; };
struct GemmP { unsigned lda2, ahs, ldb2, bhs; int K; };

__device__ __forceinline__ bool grid_order(int i, int nM, int nN, int& pm, int& pn) {
  const int nwg = nM * nN; const long L = (long)i * gridDim.x + blockIdx.x; if (L >= nwg) return false;
  int wgid = (int)L; { const int q = nwg / NXCD, r = nwg % NXCD, xcd = wgid % NXCD, off = wgid / NXCD; wgid = (xcd < r ? xcd * (q + 1) : r * (q + 1) + (xcd - r) * q) + off; }
  const int nig = WGM * nN, gid = wgid / nig, fm = gid * WGM, gsz = (nM - fm) < WGM ? (nM - fm) : WGM;
  pm = fm + ((wgid % nig) % gsz); pn = (wgid % nig) / gsz; return true;
}

template <class Epi, class Sched>
__device__ __forceinline__ void gemm_phase(LAS unsigned char* lds, const GemmP g, const Sched& S, const Epi& E, int wvid) {
  int tid = tid_fresh(wvid);
  const int wid = __builtin_amdgcn_readfirstlane(tid >> 6), lane = tid & 63, wr = wid >> 2, wc = wid & 3, fr = lane & 15, fq = lane >> 4;
  int Kop = g.K; asm volatile("" : "+s"(Kop));
  const int nt = Kop / BK;
  unsigned voffA[2], voffB[2];
#pragma unroll
  for (int i = 0; i < 2; ++i) { int R, C; stage_rc(tid * 16 + i * 8192, R, C); const int Rb = Epi::PERM ? ((R & ~31) + perm32(R & 31)) : R;
    voffA[i] = (unsigned)R * g.lda2 + (unsigned)C * 2u; voffB[i] = (unsigned)Rb * g.ldb2 + (unsigned)C * 2u; }
  const size_t kstep = (size_t)(BK * 2);
  const size_t ahs = g.ahs, bhs = g.bhs;
  const unsigned ldsw = (unsigned)wid * 1024u;
  const int aoff = lds_byte(wr * 64 + fr, fq * 8), boff = lds_byte(wc * 32 + fr, fq * 8);
#define PG8_SA(b, h) (((b) * 2 + (h)) * HTB)
#define PG8_SB(b, h) ((4 + (b) * 2 + (h)) * HTB)
#define PG8_STAGE(bufoff, gbase, voff) do { _Pragma("unroll") for (int _i = 0; _i < 2; ++_i) \
    __builtin_amdgcn_global_load_lds((const unsigned*)((const char*)(gbase) + (voff)[_i]), (LAS unsigned*)(lds + (bufoff) + ldsw + _i * 8192), 16, 0, 0); } while (0)
#define PG8_LDA(dst, b, h) do { _Pragma("unroll") for (int m = 0; m < 4; ++m) _Pragma("unroll") for (int k = 0; k < 2; ++k) dst[m][k] = *(const LAS bf16x8*)(lds + PG8_SA(b, h) + aoff + m * 2048 + k * 1024); } while (0)
#define PG8_LDB(dst, b, h) do { _Pragma("unroll") for (int n = 0; n < 2; ++n) _Pragma("unroll") for (int k = 0; k < 2; ++k) dst[n][k] = *(const LAS bf16x8*)(lds + PG8_SB(b, h) + boff + n * 2048 + k * 1024); } while (0)
#define PG8_MMA(ai, bj, At, Bt) do { __builtin_amdgcn_s_setprio(1); _Pragma("unroll") for (int m = 0; m < 4; ++m) _Pragma("unroll") for (int n = 0; n < 2; ++n) _Pragma("unroll") for (int k = 0; k < 2; ++k) \
    acc[ai][bj][m][n] = __builtin_amdgcn_mfma_f32_16x16x32_bf16(Bt[n][k], At[m][k], acc[ai][bj][m][n], 0, 0, 0); __builtin_amdgcn_s_setprio(0); } while (0)
#define PG8_WAIT_V(n) asm volatile("s_waitcnt vmcnt(" #n ")" ::: "memory")
#define PG8_WAIT_L(n) asm volatile("s_waitcnt lgkmcnt(" #n ")" ::: "memory")
#define PG8_BAR __builtin_amdgcn_s_barrier()
#define PG8_SCHED __builtin_amdgcn_sched_barrier(0)
  Unit cur, nxt; int ui = 0;
  if (!S.next(0, cur)) return;
  f32x4 acc[2][2][4][2];
#pragma unroll
  for (int a = 0; a < 2; ++a)
#pragma unroll
    for (int b = 0; b < 2; ++b)
#pragma unroll
      for (int m = 0; m < 4; ++m)
#pragma unroll
        for (int n = 0; n < 2; ++n) acc[a][b][m][n] = (f32x4){0.f, 0.f, 0.f, 0.f};
  bf16x8 At[4][2], B0[2][2], B1[2][2];
  const char* cA = cur.a; const char* cB = cur.b;
  asm volatile("" : "+s"(cA), "+s"(cB));
  PG8_STAGE(PG8_SB(0, 0), cB, voffB); PG8_STAGE(PG8_SA(0, 0), cA, voffA); PG8_STAGE(PG8_SB(0, 1), cB + bhs, voffB); PG8_STAGE(PG8_SA(0, 1), cA + ahs, voffA);
  if (wr == 1) PG8_BAR;
  PG8_WAIT_V(4); PG8_BAR;
  PG8_STAGE(PG8_SB(1, 0), cB + kstep, voffB); PG8_STAGE(PG8_SA(1, 0), cA + kstep, voffA); PG8_STAGE(PG8_SB(1, 1), cB + bhs + kstep, voffB);
  PG8_WAIT_V(6); PG8_BAR;
  for (;;) {
    const bool has_next = S.next(ui + 1, nxt);
    const char* nA = has_next ? nxt.a : cA; const char* nB = has_next ? nxt.b : cB;
    asm volatile("" : "+s"(nA), "+s"(nB));
    for (int t = 0; t < nt; t += 2) {
      const bool last = (t == nt - 2);
      const char* a1 = cA + (size_t)(t + 1) * kstep;
      const char* a2 = last ? nA : cA + (size_t)(t + 2) * kstep; const char* b2 = last ? nB : cB + (size_t)(t + 2) * kstep;
      const char* a3 = a2 + kstep; const char* b3 = b2 + kstep;
      PG8_LDB(B0, 0, 0); PG8_SCHED; PG8_LDA(At, 0, 0); PG8_STAGE(PG8_SA(1, 1), a1 + ahs, voffA);
      PG8_WAIT_L(8); PG8_BAR; PG8_WAIT_L(0); PG8_MMA(0, 0, At, B0); PG8_BAR; PG8_SCHED;
      PG8_LDB(B1, 0, 1); PG8_STAGE(PG8_SB(0, 0), b2, voffB);
      PG8_BAR; PG8_WAIT_L(0); PG8_MMA(0, 1, At, B1); PG8_BAR;
      PG8_LDA(At, 0, 1); PG8_STAGE(PG8_SA(0, 0), a2, voffA);
      PG8_BAR; PG8_WAIT_L(0); PG8_MMA(1, 0, At, B0); PG8_BAR; PG8_SCHED;
      PG8_STAGE(PG8_SB(0, 1), b2 + bhs, voffB);
      PG8_WAIT_V(6); PG8_BAR; PG8_MMA(1, 1, At, B1); PG8_BAR;
      PG8_LDB(B0, 1, 0); PG8_SCHED; PG8_LDA(At, 1, 0); PG8_STAGE(PG8_SA(0, 1), a2 + ahs, voffA);
      PG8_WAIT_L(8); PG8_BAR; PG8_WAIT_L(0); PG8_MMA(0, 0, At, B0); PG8_BAR; PG8_SCHED;
      PG8_LDB(B1, 1, 1); PG8_STAGE(PG8_SB(1, 0), b3, voffB);
      PG8_BAR; PG8_WAIT_L(0); PG8_MMA(0, 1, At, B1); PG8_BAR;
      PG8_LDA(At, 1, 1); PG8_STAGE(PG8_SA(1, 0), a3, voffA);
      PG8_BAR; PG8_WAIT_L(0); PG8_MMA(1, 0, At, B0); PG8_BAR; PG8_SCHED;
      PG8_STAGE(PG8_SB(1, 1), b3 + bhs, voffB);
      PG8_WAIT_V(6); PG8_BAR; PG8_MMA(1, 1, At, B1); PG8_BAR;
    }
    E(acc, cur, wr, wc, fr, fq);
    if (!has_next) break;
#pragma unroll
    for (int a = 0; a < 2; ++a)
#pragma unroll
      for (int b = 0; b < 2; ++b)
#pragma unroll
        for (int m = 0; m < 4; ++m)
#pragma unroll
          for (int n = 0; n < 2; ++n) acc[a][b][m][n] = (f32x4){0.f, 0.f, 0.f, 0.f};
    cur = nxt; cA = nA; cB = nB; ++ui;
  }
  PG8_WAIT_V(0);
  if (wr == 0) PG8_BAR;
  PG8_BAR;
#undef PG8_SA
#undef PG8_SB
#undef PG8_STAGE
#undef PG8_LDA
#undef PG8_LDB
#undef PG8_MMA
#undef PG8_WAIT_V
#undef PG8_WAIT_L
#undef PG8_BAR
#undef PG8_SCHED
}

#define EPI_ARGS const f32x4 (&acc)[2][2][4][2], const Unit& u, int wr, int wc, int fr, int fq
#define FOR_AM _Pragma("unroll") for (int ai = 0; ai < 2; ++ai) _Pragma("unroll") for (int m = 0; m < 4; ++m)
#define FOR_BN _Pragma("unroll") for (int bj = 0; bj < 2; ++bj) _Pragma("unroll") for (int n = 0; n < 2; ++n)

constexpr int TL_WAVE_BYTES = 16 * 80 * 2, TL_BYTES = 8 * TL_WAVE_BYTES;
template <class F>
__device__ __forceinline__ void wave_tstore(const f32x4& a0, const f32x4& a1, const f32x4& a2, const f32x4& a3, LAS bf16_t* tl, int fr, int fq, int lane, F colptr) {
  const f32x4 av[4] = {a0, a1, a2, a3};
#pragma unroll
  for (int m = 0; m < 4; ++m) { const unsigned w0 = cvt_pk_bf16(av[m][0], av[m][1]), w1 = cvt_pk_bf16(av[m][2], av[m][3]); LAS bf16_t* q = tl + (4 * fq) * 80 + 16 * m + fr;
    q[0] = (bf16_t)(w0 & 0xffffu); q[80] = (bf16_t)(w0 >> 16); q[160] = (bf16_t)(w1 & 0xffffu); q[240] = (bf16_t)(w1 >> 16); }
#pragma unroll
  for (int ps = 0; ps < 2; ++ps) { const int c = (lane >> 3) + 8 * ps; const u32x4 w = *(const LAS u32x4*)(tl + c * 80 + (lane & 7) * 8); *(u32x4*)(colptr(c) + (lane & 7) * 8) = w; }
}

struct SchedReg {
  int nM, nN; const char* A; const char* B; size_t atile, btile;
  __device__ __forceinline__ bool next(int i, Unit& u) const { int pm, pn; if (!grid_order(i, nM, nN, pm, pn)) return false; u.pm = pm; u.pn = pn; u.a = A + (size_t)pm * atile; u.b = B + (size_t)pn * btile; u.o = 0; return true; }
};
struct SchedCtxSplit {
  const char* A; const char* B; size_t atile, btile, kbytes;
  __device__ __forceinline__ bool next(int i, Unit& u) const { const int L = i * (int)gridDim.x + (int)blockIdx.x; if (L >= 128) return false;
    const int sp = L & 3, t = L >> 2, pn = t & 7, pmc = t >> 3; u.pm = pmc; u.pn = pn; u.o = (size_t)sp;
    u.a = A + (size_t)(MLAT / 256 + pmc) * atile + (size_t)sp * kbytes; u.b = B + (size_t)pn * btile + (size_t)sp * kbytes; return true; }
};
struct SchedDftCh {
  int nM; const char* A; const char* B;
  __device__ __forceinline__ bool next(int i, Unit& u) const { int pm, pn; if (!grid_order(i, nM, 8, pm, pn)) return false; u.pm = pm; u.pn = pn;
    u.a = A + (size_t)pm * (256 * 1024 * 2) + (size_t)(pn >> 1) * 512; u.b = B + (size_t)(pn & 1) * (256 * 256 * 2); u.o = 0; return true; }
};
struct SchedCtxSplitR {
  const char* A; const char* B;
  __device__ __forceinline__ bool next(int i, Unit& u) const { const int L = i * (int)gridDim.x + (int)blockIdx.x; if (L >= 64) return false;
    const int sp = L & 3, t = L >> 2, pnr = t & 3, pmc = t >> 2; u.pm = pmc; u.pn = pnr; u.o = (size_t)sp;
    u.a = A + (size_t)(MLAT / 256 + pmc) * (256 * 4096) + (size_t)sp * 1024; u.b = B + (size_t)(4 + pnr) * (256 * 4096) + (size_t)sp * 1024; return true; }
};
struct SchedGates {
  const char* A; const char* B;
  __device__ __forceinline__ bool next(int i, Unit& u) const { int pm, pn; if (!grid_order(i, MALL / 256, 16, pm, pn)) return false; u.pm = pm; u.pn = pn;
    u.a = A + (size_t)pm * (256 * 1024 * 2) + (size_t)((pn >> 1) & 3) * 512; u.b = B + (size_t)pn * (256 * 256 * 2); u.o = 0; return true; }
};
struct SchedFoldIn {
  const unsigned char* ws;
  __device__ __forceinline__ bool next(int i, Unit& u) const { if (i > 0) return false; const int L = blockIdx.x; if (L >= 128) return false;
    const int l = L >> 6, g = (L >> 4) & 3, pm = (L >> 3) & 1, pn = L & 7; u.pm = pm; u.pn = pn;
    u.a = (const char*)ws + OFF_CST + (size_t)pm * (256 * 256 * 2);
    u.b = (const char*)ws + OFF_W + l * W_LAYER + W_WINNAT + ((size_t)pn * 256 * 1024 + g * 256) * 2;
    u.o = OFF_W + l * W_LAYER + W_WINT + ((size_t)(g * 512 + pm * 256) * 2048 + pn * 256) * 2; return true; }
};
struct SchedFoldOut {
  const unsigned char* ws;
  __device__ __forceinline__ bool next(int i, Unit& u) const { if (i > 0) return false; const int L = (int)blockIdx.x - 128; if (L < 0 || L >= 64) return false;
    const int l = L >> 5, g = (L >> 3) & 3, pm = L & 7; u.pm = pm; u.pn = 0;
    u.a = (const char*)ws + OFF_W + l * W_LAYER + W_WOUTRAW + ((size_t)pm * 256 * 1024 + g * 256) * 2;
    u.b = (const char*)ws + OFF_W + l * W_LAYER + W_WFNAT + (size_t)g * 65536 * 2;
    u.o = OFF_W + l * W_LAYER + W_WOUTT + ((size_t)(pm * 256) * 2048 + g * 256) * 2; return true; }
};
struct SchedF2 {
  const char* P1; const char* D2m;
  __device__ __forceinline__ bool next(int i, Unit& u) const { const int L = i * (int)gridDim.x + (int)blockIdx.x; if (L >= 1024) return false;
    const int b = L >> 8, g = (L >> 6) & 3, j = L & 63; u.pm = b * 4 + g; u.pn = j;
    u.a = P1 + ((size_t)((b * 128) * 4 + g) * 256 + 4 * j) * 128 * 2; u.b = D2m; u.o = 0; return true; }
};
struct SchedF3 {
  const char* Q; const char* D3m;
  __device__ __forceinline__ bool next(int i, Unit& u) const { const int L = i * (int)gridDim.x + (int)blockIdx.x; if (L >= 512) return false;
    const int b = L >> 7, g = (L >> 5) & 3, e = L & 31; u.pm = b * 4 + g; u.pn = e;
    u.a = Q + ((size_t)((b * 4 + g) * 256) * 64 + 2 * e) * 256 * 2; u.b = D3m; u.o = 0; return true; }
};
struct SchedF2c {
  const char* P1c; const char* DCm;
  __device__ __forceinline__ bool next(int i, Unit& u) const { if (i > 0) return false; const int L = (int)gridDim.x - 1 - (int)blockIdx.x; if (L >= 16) return false;
    u.pm = L; u.pn = 0; u.a = P1c + (size_t)(L * 256) * 512 * 2; u.b = DCm; u.o = 0; return true; }
};

struct EpiStore {
  static constexpr bool PERM = false;
  unsigned char* ws; int ldc;
  __device__ __forceinline__ void operator()(EPI_ARGS) const {
    bf16_t* base = (bf16_t*)(ws + u.o);
    FOR_AM { const int rr = 128 * ai + 64 * wr + 16 * m + fr;
      FOR_BN st4bf(base + (size_t)rr * ldc + 128 * bj + 32 * wc + 16 * n + 4 * fq, acc[ai][bj][m][n]); asm volatile("" ::: "memory"); }
  }
};
__device__ __forceinline__ void st8bf(bf16_t* p, f32x4 v0, f32x4 v1) { u32x4 w; w.x = cvt_pk_bf16(v0[0], v0[1]); w.y = cvt_pk_bf16(v0[2], v0[3]); w.z = cvt_pk_bf16(v1[0], v1[1]); w.w = cvt_pk_bf16(v1[2], v1[3]); *(u32x4*)p = w; }
struct EpiG1 {
  static constexpr bool PERM = true;
  bf16_t* FB; bf16_t* R; bf16_t* GG;
  __device__ __forceinline__ void operator()(EPI_ARGS) const {
    const int pm = u.pm, pn = u.pn;
    if (pn < 8) {
      bf16_t* dst = pn < 4 ? FB + pn * 256 : R + (pn - 4) * 256;
      FOR_AM { const int rr = 128 * ai + 64 * wr + 16 * m + fr; bf16_t* rowp = dst + (size_t)(pm * 256 + rr) * 1024 + 32 * wc + 8 * fq;
        st8bf(rowp, acc[ai][0][m][0], acc[ai][0][m][1]); st8bf(rowp + 128, acc[ai][1][m][0], acc[ai][1][m][1]); }
    } else {
      FOR_AM { const int rr = 128 * ai + 64 * wr + 16 * m + fr; bf16_t* rowp = GG + (size_t)(pm * 256 + rr) * 1024 + (pn - 8) * 256 + 32 * wc + 8 * fq;
#pragma unroll
        for (int bj = 0; bj < 2; ++bj) { f32x4 v0 = acc[ai][bj][m][0], v1 = acc[ai][bj][m][1];
#pragma unroll
          for (int i = 0; i < 4; ++i) { v0[i] = gelu_tanh(v0[i]); v1[i] = gelu_tanh(v1[i]); }
          st8bf(rowp + 128 * bj, v0, v1); }
        }
    }
  }
};
struct EpiDftCh {
  static constexpr bool PERM = false;
  bf16_t* P1; bf16_t* P1c; LAS unsigned char* tlb;
  __device__ __forceinline__ void operator()(EPI_ARGS) const {
    const int pm = u.pm, pn = u.pn;
    const int g = pn >> 1, ri = pn & 1, lane = fr + 16 * fq; LAS bf16_t* tl = (LAS bf16_t*)(tlb + (wr * 4 + wc) * TL_WAVE_BYTES);
#pragma unroll
    for (int ai = 0; ai < 2; ++ai) {
      bf16_t* rowp; int ks;
      if (pm < 128) { const int b = pm >> 5, n1 = 4 * (pm & 31) + 2 * ai + wr; rowp = P1 + ((size_t)((b * 128 + n1) * 4 + g) * 256 * 2 + ri) * 64; ks = 128; }
      else { const int b = pm - 128; rowp = P1c + ((size_t)((b * 4 + g) * 256) * 2 + ri) * 256 + 128 * ai + 64 * wr; ks = 512; }
      FOR_BN { const int k30 = 128 * bj + 32 * wc + 16 * n;
        wave_tstore(acc[ai][bj][0][n], acc[ai][bj][1][n], acc[ai][bj][2][n], acc[ai][bj][3][n], tl, fr, fq, lane, [&](int c) { return rowp + (size_t)(k30 + c) * ks; }); }
      asm volatile("" ::: "memory"); }
  }
};
struct EpiF2 {
  static constexpr bool PERM = false;
  bf16_t* Q; LAS unsigned char* tlb;
  __device__ __forceinline__ void operator()(EPI_ARGS) const {
    const int bg = u.pm, j = u.pn, rip = wc >> 1, lane = fr + 16 * fq; LAS bf16_t* tl = (LAS bf16_t*)(tlb + (wr * 4 + wc) * TL_WAVE_BYTES);
#pragma unroll
    for (int ai = 0; ai < 2; ++ai) {
      FOR_BN { const int k3 = 4 * j + 2 * ai + bj, k20 = 32 * (wc & 1) + 16 * n;
        bf16_t* base = Q + (((size_t)(bg * 256 + k3) * 64 + k20) * 2 + rip) * 128 + 64 * wr;
        wave_tstore(acc[ai][bj][0][n], acc[ai][bj][1][n], acc[ai][bj][2][n], acc[ai][bj][3][n], tl, fr, fq, lane, [&](int c) { return base + (size_t)c * 256; }); }
      asm volatile("" ::: "memory"); }
  }
};
template <bool CTX> struct EpiF3 {
  static constexpr bool PERM = false;
  bf16_t* M2; LAS unsigned char* tlb;
  __device__ __forceinline__ void operator()(EPI_ARGS) const {
    const int b = u.pm >> 2, g = u.pm & 3, e = u.pn, lane = fr + 16 * fq; LAS bf16_t* tl = (LAS bf16_t*)(tlb + (wr * 4 + wc) * TL_WAVE_BYTES);
#pragma unroll
    for (int ai = 0; ai < 2; ++ai) {
      FOR_BN { size_t tok0, tstep;
        if (CTX) { tok0 = (size_t)MLAT + b * 256 + (128 * bj + 32 * wc + 16 * n); tstep = 1; }
        else { const int k10 = 32 * wc + 16 * n, k2 = 2 * e + bj; tok0 = (size_t)b * SEQ + k10 * 64 + k2; tstep = 64; }
        bf16_t* base = M2 + tok0 * D + g * 256 + 128 * ai + 64 * wr; const size_t ts = tstep * D;
        wave_tstore(acc[ai][bj][0][n], acc[ai][bj][1][n], acc[ai][bj][2][n], acc[ai][bj][3][n], tl, fr, fq, lane, [&](int c) { return base + (size_t)c * ts; }); }
      asm volatile("" ::: "memory"); }
  }
};
struct EpiGates {
  static constexpr bool PERM = true;
  const bf16_t* U; bf16_t* LA; bf16_t* BX; const float* lb; const float* sp8t;
  __device__ __forceinline__ void operator()(EPI_ARGS) const {
    const int pm = u.pm, pn = u.pn, d = pn >> 3, h = (pn >> 1) & 3, half = pn & 1;
    const int ch = h * 256 + half * 128 + 32 * wc + 8 * fq;
    const size_t rowb = (size_t)pm * 256 + 64 * wr + fr;
    u32x4 uu[2][4]; f32x4 br[2], bi[2], sp8[2];
#pragma unroll
    for (int n = 0; n < 2; ++n) { br[n] = *(const f32x4*)(lb + (d * 2 + 0) * 1024 + ch + 4 * n); bi[n] = *(const f32x4*)(lb + (d * 2 + 1) * 1024 + ch + 4 * n); sp8[n] = *(const f32x4*)(sp8t + d * 1024 + ch + 4 * n); }
    FOR_AM uu[ai][m] = *(const u32x4*)(U + (rowb + 128 * ai + 16 * m) * 1024 + ch);
    FOR_AM { const size_t row = rowb + 128 * ai + 16 * m; const u32x4 uw = uu[ai][m];
      const float uv[2][4] = {{bf_lo(uw.x), bf_hi(uw.x), bf_lo(uw.y), bf_hi(uw.y)}, {bf_lo(uw.z), bf_hi(uw.z), bf_lo(uw.w), bf_hi(uw.w)}};
      f32x4 la[2], bx[2];
#pragma unroll
      for (int n = 0; n < 2; ++n)
#pragma unroll
        for (int hh = 0; hh < 2; ++hh) { const int i0 = 2 * hh; f32x2 l2, b2;
          gates_pk((f32x2){acc[ai][0][m][n][i0] + br[n][i0], acc[ai][0][m][n][i0 + 1] + br[n][i0 + 1]}, (f32x2){acc[ai][1][m][n][i0] + bi[n][i0], acc[ai][1][m][n][i0 + 1] + bi[n][i0 + 1]},
                   (f32x2){sp8[n][i0], sp8[n][i0 + 1]}, (f32x2){uv[n][i0], uv[n][i0 + 1]}, l2, b2);
          la[n][i0] = l2.x; la[n][i0 + 1] = l2.y; bx[n][i0] = b2.x; bx[n][i0 + 1] = b2.y; }
      st8bf(LA + row * 2048 + d * 1024 + ch, la[0], la[1]); st8bf(BX + row * 2048 + d * 1024 + ch, bx[0], bx[1]); }
  }
};
struct EpiSlab {
  static constexpr bool PERM = false;
  float* FS;
  __device__ __forceinline__ void operator()(EPI_ARGS) const {
    FOR_AM { float* rowp = FS + ((size_t)u.o * MCTX + u.pm * 256 + 128 * ai + 64 * wr + 16 * m + fr) * D + u.pn * 256;
      FOR_BN *(f32x4*)(rowp + 128 * bj + 32 * wc + 16 * n + 4 * fq) = acc[ai][bj][m][n]; asm volatile("" ::: "memory"); }
  }
};
struct EpiSlabR {
  static constexpr bool PERM = false;
  float* FS;
  __device__ __forceinline__ void operator()(EPI_ARGS) const {
    FOR_AM { float* rowp = FS + ((size_t)u.o * MCTX + u.pm * 256 + 128 * ai + 64 * wr + 16 * m + fr) * 1024 + u.pn * 256;
      FOR_BN *(f32x4*)(rowp + 128 * bj + 32 * wc + 16 * n + 4 * fq) = acc[ai][bj][m][n]; asm volatile("" ::: "memory"); }
  }
};
struct EpiYSS {
  static constexpr bool PERM = true;
  bf16_t* Y; float* rssp;
  __device__ __forceinline__ void operator()(EPI_ARGS) const {
    FOR_AM { const size_t row = (size_t)u.pm * 256 + 128 * ai + 64 * wr + 16 * m + fr; float s = 0.f;
      FOR_BN { const f32x4 v = acc[ai][bj][m][n]; s += v[0] * v[0] + v[1] * v[1] + v[2] * v[2] + v[3] * v[3]; }
      bf16_t* rowp = Y + row * D + u.pn * 256 + 32 * wc + 8 * fq;
      st8bf(rowp, acc[ai][0][m][0], acc[ai][0][m][1]); st8bf(rowp + 128, acc[ai][1][m][0], acc[ai][1][m][1]);
      s += __shfl_xor(s, 16); s += __shfl_xor(s, 32);
      if (fq == 0) rssp[row * 32 + u.pn * 4 + wc] = s; }
  }
};
struct EpiSwiGLU {
  static constexpr bool PERM = true;
  bf16_t* ACT;
  __device__ __forceinline__ void operator()(EPI_ARGS) const {
    FOR_AM { const size_t row = (size_t)u.pm * 256 + 128 * ai + 64 * wr + 16 * m + fr; f32x4 o0, o1;
      { const f32x4 g0 = acc[ai][0][m][0], g1 = acc[ai][0][m][1], u0 = acc[ai][1][m][0], u1 = acc[ai][1][m][1];
        const f32x2 a = swiglu_pk((f32x2){g0[0], g0[1]}, (f32x2){u0[0], u0[1]}), b = swiglu_pk((f32x2){g0[2], g0[3]}, (f32x2){u0[2], u0[3]});
        const f32x2 c = swiglu_pk((f32x2){g1[0], g1[1]}, (f32x2){u1[0], u1[1]}), d = swiglu_pk((f32x2){g1[2], g1[3]}, (f32x2){u1[2], u1[3]});
        o0 = (f32x4){a.x, a.y, b.x, b.y}; o1 = (f32x4){c.x, c.y, d.x, d.y}; }
      st8bf(ACT + row * DFF + u.pn * 128 + 32 * wc + 8 * fq, o0, o1); }
  }
};

template <class F>
__device__ __forceinline__ void transpose_job(const float* __restrict__ src, int srcld, int K, int NR, bf16_t* __restrict__ dst, int dstld, F off, float* tile, int& tbase, int tid, int G, int cwg) {
  const int nkt = K / 64, ntile = nkt * (NR / 64);
  int t = (cwg - tbase % G + G) % G;
  float r[8];
  if (t < ntile) { const int k0 = (t % nkt) * 64, r0 = (t / nkt) * 64;
#pragma unroll
    for (int e = 0; e < 8; ++e) { const int idx = tid + 512 * e, kk = idx >> 6, nn = idx & 63; r[e] = src[(size_t)off(r0 + nn) + (size_t)(k0 + kk) * srcld]; } }
  for (; t < ntile; t += G) {
    const int k0 = (t % nkt) * 64, r0 = (t / nkt) * 64, tn = t + G; float rn[8];
    if (tn < ntile) { const int k1 = (tn % nkt) * 64, r1 = (tn / nkt) * 64;
#pragma unroll
      for (int e = 0; e < 8; ++e) { const int idx = tid + 512 * e, kk = idx >> 6, nn = idx & 63; rn[e] = src[(size_t)off(r1 + nn) + (size_t)(k1 + kk) * srcld]; } }
#pragma unroll
    for (int e = 0; e < 8; ++e) { const int idx = tid + 512 * e, kk = idx >> 6, nn = idx & 63; tile[kk * 65 + nn] = r[e]; }
    __syncthreads();
#pragma unroll
    for (int e = 0; e < 4; ++e) { const int idx = tid + 512 * e, nn = idx >> 5, kp = idx & 31;
      *(unsigned*)(dst + (size_t)(r0 + nn) * dstld + k0 + 2 * kp) = cvt_pk_bf16(tile[(2 * kp) * 65 + nn], tile[(2 * kp + 1) * 65 + nn]); }
    __syncthreads();
#pragma unroll
    for (int e = 0; e < 8; ++e) r[e] = rn[e];
  }
  tbase += ntile;
}
struct OffId { int add; __device__ __forceinline__ size_t operator()(int r) const { return (size_t)(r + add); } };
struct OffGates { __device__ __forceinline__ size_t operator()(int r) const { const int pn = r >> 8, d = pn >> 3, h = (pn >> 1) & 3, half = pn & 1, w = r & 255, gate = w >> 7;
  return (size_t)(((d * 2 + gate) * 4 + h)) * 65536 + half * 128 + (w & 127); } };
struct OffSwi { __device__ __forceinline__ size_t operator()(int r) const { const int pn = r >> 8, w = r & 255; return (size_t)(w >> 7) * DFF + pn * 128 + (w & 127); } };

__device__ __forceinline__ void prep_a(const P& p, unsigned char* shm, int wvid) {
  const int tid = tid_fresh(wvid);
  const size_t gtid = (size_t)blockIdx.x * 512 + tid, nth = (size_t)gridDim.x * 512;
  unsigned char* ws = p.ws;
  { bf16_t* CST = (bf16_t*)(ws + OFF_CST); bf16_t* D2m = (bf16_t*)(ws + OFF_D2); bf16_t* D3m = (bf16_t*)(ws + OFF_D3); bf16_t* DCm = (bf16_t*)(ws + OFF_DC);
    for (size_t i = gtid; i < 512 * 256; i += nth) { const int j = (int)(i >> 8), c = (int)(i & 255), t = (c * (j & 255)) & 255; const float ang = (float)t * (2.0f / 256.0f);
      const float v = (j < 256 ? cospif(ang) : -sinpif(ang)) * (1.0f / 16.0f); CST[i] = (bf16_t)(cvt_pk_bf16(v, 0.f) & 0xffffu); }
    for (size_t i = gtid; i < 256 * 256; i += nth) { const int np = (int)(i >> 8), k = (int)(i & 255), parp = np >> 7, rip = (np >> 6) & 1, k2 = np & 63, par = k >> 7, ri = (k >> 6) & 1, n2 = k & 63;
      const float ang = (float)((k2 * n2) & 63) * (2.0f / 64.0f), cs = cospif(ang) * 0.125f, sn = sinpif(ang) * 0.125f;
      const float v = par != parp ? 0.f : (rip == 0 ? (ri == 0 ? cs : sn) : (ri == 0 ? -sn : cs)); D2m[i] = (bf16_t)(cvt_pk_bf16(v, 0.f) & 0xffffu); }
    for (size_t i = gtid; i < 256 * 512; i += nth) { const int np = (int)(i >> 9), k = (int)(i & 511), qp = np >> 7, k1 = np & 127, q = k >> 8, ri = (k >> 7) & 1, n1 = k & 127;
      const float ang = (float)((k1 * n1) & 127) * (2.0f / 128.0f); const float v = q != qp ? 0.f : (ri == 0 ? cospif(ang) : sinpif(ang)) * 0.08838834764831845f;
      D3m[i] = (bf16_t)(cvt_pk_bf16(v, 0.f) & 0xffffu); }
    for (size_t i = gtid; i < 256 * 512; i += nth) { const int kp = (int)(i >> 9), k = (int)(i & 511), ri = k >> 8, t = k & 255;
      const float ang = (float)((kp * t) & 255) * (2.0f / 256.0f); const float v = (ri == 0 ? cospif(ang) : sinpif(ang)) * (1.0f / 16.0f);
      DCm[i] = (bf16_t)(cvt_pk_bf16(v, 0.f) & 0xffffu); } }
  { float* SP8 = (float*)(ws + OFF_SP8); for (size_t i = gtid; i < 4096; i += nth) SP8[i] = 8.0f * log1pf(__expf(-p.lru_lam[i])); }
  for (size_t i = gtid; i < (size_t)2 * 65536; i += nth) { const int l = (int)(i >> 16), r = (int)(i & 65535);
    const f32x4 v = *(const f32x4*)(p.w_four + (size_t)l * 262144 + r * 4); st4bf((bf16_t*)(ws + OFF_W + l * W_LAYER + W_WFNAT) + r * 4, v); }
  float* tile = (float*)shm; int tbase = 0; const int G = gridDim.x, cwg = blockIdx.x;
  for (int l = 0; l < DEPTH; ++l) {
    unsigned char* wl = ws + OFF_W + l * W_LAYER;
    if (l == 0) {
      transpose_job(p.w_ffn_in + (size_t)l * 2048 * 11264, 11264, 2048, 11264, (bf16_t*)(wl + W_WFFI), 2048, OffSwi{}, tile, tbase, tid, G, cwg);
      transpose_job(p.w_ffn_out + (size_t)l * DFF * 2048, 2048, DFF, 2048, (bf16_t*)(wl + W_WFFO), DFF, OffId{0}, tile, tbase, tid, G, cwg);
      transpose_job(p.w_in + (size_t)l * 2048 * 3072, 3072, 2048, 3072, (bf16_t*)(wl + W_WINT), 2048, OffId{0}, tile, tbase, tid, G, cwg);
      transpose_job(p.lru_w + (size_t)l * 16 * 65536, 256, 256, 4096, (bf16_t*)(wl + W_WGT), 256, OffGates{}, tile, tbase, tid, G, cwg); }
    transpose_job(p.w_out + (size_t)l * 2048 * 2048, 2048, 1024, 2048, (bf16_t*)(wl + W_WOUTRAW), 1024, OffId{0}, tile, tbase, tid, G, cwg);
    transpose_job(p.w_out + (size_t)l * 2048 * 2048 + (size_t)1024 * 2048, 2048, 1024, 2048, (bf16_t*)(wl + W_WOUTT) + 1024, 2048, OffId{0}, tile, tbase, tid, G, cwg);
  }
  float* sl = (float*)shm;
  __syncthreads();
  for (int i = tid; i < 5 * 2048; i += 512) { const int r = i >> 11, dd = i & 2047; const float cv = r < 4 ? p.c[r * 2048 + dd] : p.c_ctx[dd]; sl[i] = cv * sigmoidf_(cv); }
  __syncthreads();
  for (size_t it = gtid; it < (size_t)2 * 3072 * 16; it += nth) {
    const int cgp = (int)(it % 3072), rest = (int)(it / 3072), kc = rest & 15, l = rest >> 4;
    f32x4 a0 = {0.f, 0.f, 0.f, 0.f}, a1 = a0, a2 = a0, a3 = a0, a4 = a0;
    const float* wp = p.w_ada + ((size_t)l * 2048 + kc * 128) * 12288 + cgp * 4;
#pragma unroll 8
    for (int dd = 0; dd < 128; ++dd) { const f32x4 w = *(const f32x4*)(wp + (size_t)dd * 12288); const int d0 = kc * 128 + dd;
      a0 += sl[d0] * w; a1 += sl[2048 + d0] * w; a2 += sl[4096 + d0] * w; a3 += sl[6144 + d0] * w; a4 += sl[8192 + d0] * w; }
    if (kc == 0) { const f32x4 bb = *(const f32x4*)(p.b_ada + (size_t)l * 12288 + cgp * 4); a0 += bb; a1 += bb; a2 += bb; a3 += bb; a4 += bb; }
    int* mp = (int*)(ws + OFF_MOD) + (size_t)l * 5 * 12288 + cgp * 4;
#pragma unroll
    for (int j = 0; j < 4; ++j) { atomicAdd(mp + j, __float2int_rn(a0[j] * FX)); atomicAdd(mp + 12288 + j, __float2int_rn(a1[j] * FX)); atomicAdd(mp + 2 * 12288 + j, __float2int_rn(a2[j] * FX));
      atomicAdd(mp + 3 * 12288 + j, __float2int_rn(a3[j] * FX)); atomicAdd(mp + 4 * 12288 + j, __float2int_rn(a4[j] * FX)); }
  }
}

__device__ __forceinline__ void prep_late(const P& p, unsigned char* shm, int wvid, int first_idle) {
  const int cwg = (int)blockIdx.x - first_idle, G = (int)gridDim.x - first_idle; if (cwg < 0) return;
  const int tid = tid_fresh(wvid); float* tile = (float*)shm; int tbase = 0; const int l = 1; unsigned char* wl = p.ws + OFF_W + l * W_LAYER;
  transpose_job(p.w_ffn_in + (size_t)l * 2048 * 11264, 11264, 2048, 11264, (bf16_t*)(wl + W_WFFI), 2048, OffSwi{}, tile, tbase, tid, G, cwg);
  transpose_job(p.w_ffn_out + (size_t)l * DFF * 2048, 2048, DFF, 2048, (bf16_t*)(wl + W_WFFO), DFF, OffId{0}, tile, tbase, tid, G, cwg);
  transpose_job(p.w_in + (size_t)l * 2048 * 3072, 3072, 2048, 3072, (bf16_t*)(wl + W_WINT), 2048, OffId{0}, tile, tbase, tid, G, cwg);
  transpose_job(p.lru_w + (size_t)l * 16 * 65536, 256, 256, 4096, (bf16_t*)(wl + W_WGT), 256, OffGates{}, tile, tbase, tid, G, cwg);
}

__device__ __forceinline__ float* xrow(const P& p, int row) { return (float*)(p.ws + OFF_XC) + (size_t)(row - MLAT) * D; }
__device__ __forceinline__ const float* xin_row(const P& p, int row) { return row < MLAT ? p.x + (size_t)row * D : p.ctx + (size_t)(row - MLAT) * D; }

__device__ __forceinline__ void norm_mod_store(const f32x4 (&v)[8], const float* __restrict__ g, const float* __restrict__ shift, const float* __restrict__ scale, bf16_t* __restrict__ hrow, int lane) {
  float ss = 0.f;
#pragma unroll
  for (int q = 0; q < 8; ++q) ss += v[q][0] * v[q][0] + v[q][1] * v[q][1] + v[q][2] * v[q][2] + v[q][3] * v[q][3];
  ss = wave_sum(ss); const float rstd = rsqrtf(ss * (1.0f / D) + EPS);
  u32x2 hp[8];
#pragma unroll
  for (int q = 0; q < 8; ++q) { const int col = q * 256 + lane * 4; const f32x4 gg = *(const f32x4*)(g + col), sc = *(const f32x4*)(scale + col), sh = *(const f32x4*)(shift + col);
    f32x4 h;
#pragma unroll
    for (int i = 0; i < 4; ++i) h[i] = v[q][i] * rstd * gg[i] * (1.0f + sc[i]) + sh[i];
    hp[q].x = cvt_pk_bf16(h[0], h[1]); hp[q].y = cvt_pk_bf16(h[2], h[3]); }
#pragma unroll
  for (int q = 0; q < 8; ++q) *(u32x2*)(hrow + q * 256 + lane * 4) = hp[q];
}
__device__ __forceinline__ void norm_mod_store_r(const f32x4 (&v)[8], const f32x4 (&gb)[8], const f32x4 (&gc)[8], bf16_t* __restrict__ hrow, int lane) {
  float ss = 0.f;
#pragma unroll
  for (int q = 0; q < 8; ++q) ss += v[q][0] * v[q][0] + v[q][1] * v[q][1] + v[q][2] * v[q][2] + v[q][3] * v[q][3];
  ss = wave_sum(ss); const float rstd = rsqrtf(ss * (1.0f / D) + EPS);
  u32x2 hp[8];
#pragma unroll
  for (int q = 0; q < 8; ++q) { const f32x4 h = v[q] * rstd * gb[q] + gc[q]; hp[q].x = cvt_pk_bf16(h[0], h[1]); hp[q].y = cvt_pk_bf16(h[2], h[3]); }
#pragma unroll
  for (int q = 0; q < 8; ++q) *(u32x2*)(hrow + q * 256 + lane * 4) = hp[q];
}
__device__ __forceinline__ void phase_e0(const P& p, const float* MOD  , int wvid) {
  const int tf = tid_fresh(wvid), lane = tf & 63, wv = blockIdx.x * 8 + (tf >> 6), nwv = gridDim.x * 8;
  bf16_t* H = (bf16_t*)(p.ws + OFF_H);
  if (nwv == 2048) {
    const int bb = wv & 3, r0 = bb * SEQ + (wv >> 2); const float* md = MOD + (size_t)bb * 4096;
    f32x4 gb[8], gc[8];
#pragma unroll
    for (int q = 0; q < 8; ++q) { const int col = q * 256 + lane * 4; gb[q] = *(const f32x4*)(p.norm_g + col) * (*(const f32x4*)(md + 2048 + col) + 1.0f); gc[q] = *(const f32x4*)(md + col); }
    f32x4 v[8];
#pragma unroll
    for (int q = 0; q < 8; ++q) v[q] = *(const f32x4*)(p.x + (size_t)r0 * D + q * 256 + lane * 4);
#pragma unroll 1
    for (int k = 0; k < 16; ++k) { const int row = r0 + 512 * k; f32x4 vn[8];
      if (k < 15) {
#pragma unroll
        for (int q = 0; q < 8; ++q) vn[q] = *(const f32x4*)(p.x + (size_t)(row + 512) * D + q * 256 + lane * 4); }
      norm_mod_store_r(v, gb, gc, H + (size_t)row * D, lane);
#pragma unroll
      for (int q = 0; q < 8; ++q) v[q] = vn[q]; }
    for (int row = MLAT + wv; row < MALL; row += nwv) { const float* src = xin_row(p, row); const float* mdc = MOD + (size_t)4 * 4096; f32x4 vc[8];
#pragma unroll
      for (int q = 0; q < 8; ++q) vc[q] = *(const f32x4*)(src + q * 256 + lane * 4);
      norm_mod_store(vc, p.norm_g, mdc, mdc + 2048, H + (size_t)row * D, lane); }
    return;
  }
  for (int row = wv; row < MALL; row += nwv) { const float* src = xin_row(p, row); const int mr = row < MLAT ? row / SEQ : 4; const float* md = MOD + (size_t)mr * 4096; f32x4 v[8];
#pragma unroll
    for (int q = 0; q < 8; ++q) v[q] = *(const f32x4*)(src + q * 256 + lane * 4);
    norm_mod_store(v, p.norm_g, md, md + 2048, H + (size_t)row * D, lane); }
}
__device__ __forceinline__ void phase_res(const P& p, int l, int which  , int nrows, bool ctx_slabs, int wvid) {
  const int tf = tid_fresh(wvid), lane = tf & 63, wv = blockIdx.x * 8 + (tf >> 6), nwv = gridDim.x * 8;
  const float* MOD = (const float*)(p.ws + OFF_MODF); bf16_t* H = (bf16_t*)(p.ws + OFF_H);
  const bf16_t* Y = (const bf16_t*)(p.ws + (which == 0 ? OFF_A : OFF_M2));
  const float* rssp = (const float*)(p.ws + OFF_RSSP) + (lane & 31);
  const float* gpost = p.norm_g + (size_t)(l * 4 + (which == 0 ? 1 : 3)) * D;
  const bool donext = (which == 0) || (l + 1 < DEPTH);
  const int ln = which == 0 ? l : l + 1;
  const float* gnext = p.norm_g + (size_t)(ln * 4 + (which == 0 ? 2 : 0)) * D;
  const bool from_in = (l == 0 && which == 0);
  const int so = which == 0 ? 3 : 0;
  {
    const int bb = wv & 3, r0 = bb * SEQ + (wv >> 2); const float* md = MOD + ((size_t)l * 5 + bb) * 12288; const float* mdn = MOD + ((size_t)ln * 5 + bb) * 12288;
    bf16_t* XB = (bf16_t*)p.out; const bool final_out = !donext;
    f32x4 ga[8], gb[8], gc[8];
#pragma unroll
    for (int q = 0; q < 8; ++q) { const int col = q * 256 + lane * 4; ga[q] = *(const f32x4*)(gpost + col) * *(const f32x4*)(md + (which == 0 ? 2 : 5) * 2048 + col);
      if (donext) { gb[q] = *(const f32x4*)(gnext + col) * (*(const f32x4*)(mdn + (so + 1) * 2048 + col) + 1.0f); gc[q] = *(const f32x4*)(mdn + so * 2048 + col); } }
    f32x4 v[8]; u32x2 xx[8], yy[8]; float rs;
#pragma unroll
    for (int q = 0; q < 8; ++q) { const int col = q * 256 + lane * 4; yy[q] = *(const u32x2*)(Y + (size_t)r0 * D + col);
      if (from_in) v[q] = *(const f32x4*)(p.x + (size_t)r0 * D + col); else xx[q] = *(const u32x2*)(XB + (size_t)r0 * (2 * D) + col); }
    rs = lane < 32 ? rssp[(size_t)r0 * 32] : 0.f;
#pragma unroll 1
    for (int k = 0; k < 16; ++k) { const int row = r0 + 512 * k; f32x4 vn[8]; u32x2 xn[8], yn[8]; float rsn = 0.f;
      if (k < 15) { const int nx = row + 512;
#pragma unroll
        for (int q = 0; q < 8; ++q) { const int col = q * 256 + lane * 4; yn[q] = *(const u32x2*)(Y + (size_t)nx * D + col);
          if (from_in) vn[q] = *(const f32x4*)(p.x + (size_t)nx * D + col); else xn[q] = *(const u32x2*)(XB + (size_t)nx * (2 * D) + col); }
        rsn = lane < 32 ? rssp[(size_t)nx * 32] : 0.f; }
      const float rstd = rsqrtf(wave_sum(rs) * (1.0f / D) + EPS);
#pragma unroll
      for (int q = 0; q < 8; ++q) { const f32x4 yv = {bf_lo(yy[q].x), bf_hi(yy[q].x), bf_lo(yy[q].y), bf_hi(yy[q].y)};
        if (!from_in) v[q] = (f32x4){bf_lo(xx[q].x), bf_hi(xx[q].x), bf_lo(xx[q].y), bf_hi(xx[q].y)};
        v[q] = v[q] + yv * rstd * ga[q]; }
      if (final_out) {
#pragma unroll
        for (int q = 0; q < 8; ++q) *(f32x4*)(p.out + (size_t)row * D + q * 256 + lane * 4) = v[q];
      } else {
#pragma unroll
        for (int q = 0; q < 8; ++q) { u32x2 xo; xo.x = cvt_pk_bf16(v[q][0], v[q][1]); xo.y = cvt_pk_bf16(v[q][2], v[q][3]); *(u32x2*)(XB + (size_t)row * (2 * D) + q * 256 + lane * 4) = xo; }
        norm_mod_store_r(v, gb, gc, H + (size_t)row * D, lane); }
#pragma unroll
      for (int q = 0; q < 8; ++q) { if (from_in) v[q] = vn[q]; else xx[q] = xn[q]; yy[q] = yn[q]; }
      rs = rsn; }
  }
}
__device__ __forceinline__ void phase_res_ctx(const P& p, int l, int which, float* xlds  , int wvid) {
  const int tf = tid_fresh(wvid), lane = tf & 63, wv = blockIdx.x * 8 + (tf >> 6), nwv = gridDim.x * 8;
  const float* MOD = (const float*)(p.ws + OFF_MODF); bf16_t* H = (bf16_t*)(p.ws + OFF_H);
  const float* gpost = p.norm_g + (size_t)(l * 4 + (which == 0 ? 1 : 3)) * D;
  const bool donext = (which == 0) || (l + 1 < DEPTH);
  const int ln = which == 0 ? l : l + 1;
  const float* gnext = p.norm_g + (size_t)(ln * 4 + (which == 0 ? 2 : 0)) * D;
  const bool from_in = (l == 0 && which == 0);
  const int so = which == 0 ? 3 : 0;
  {
    const float* FS = (const float*)(p.ws + OFF_FS); float* xl = xlds + (tf >> 6) * 2048;
    const float* md = MOD + ((size_t)l * 5 + 4) * 12288; const float* gate = md + (which == 0 ? 2 : 5) * 2048; const float* mdn = MOD + ((size_t)ln * 5 + 4) * 12288;
#pragma unroll 1
    for (int rc = wv; rc < MCTX; rc += nwv) { const int rw = MLAT + rc;
      const float* src = from_in ? xin_row(p, rw) : xrow(p, rw); float* dstx = xrow(p, rw); const float* fp0 = FS + (size_t)rc * D + lane * 4;
      float ss = 0.f;
#pragma unroll 1
      for (int q = 0; q < 8; ++q) { const float* fp = fp0 + q * 256;
        const f32x4 y = *(const f32x4*)fp + *(const f32x4*)(fp + (size_t)MCTX * D) + *(const f32x4*)(fp + (size_t)2 * MCTX * D) + *(const f32x4*)(fp + (size_t)3 * MCTX * D);
        ss += y[0] * y[0] + y[1] * y[1] + y[2] * y[2] + y[3] * y[3]; }
      ss = wave_sum_l(ss, lane); const float rstd = rsqrtf(ss * (1.0f / D) + EPS); float s2 = 0.f;
#pragma unroll 1
      for (int q = 0; q < 8; ++q) { const int col = q * 256 + lane * 4; const float* fp = fp0 + q * 256;
        const f32x4 y = *(const f32x4*)fp + *(const f32x4*)(fp + (size_t)MCTX * D) + *(const f32x4*)(fp + (size_t)2 * MCTX * D) + *(const f32x4*)(fp + (size_t)3 * MCTX * D);
        const f32x4 x1 = *(const f32x4*)(src + col) + *(const f32x4*)(gate + col) * (y * rstd * *(const f32x4*)(gpost + col));
        *(f32x4*)(dstx + col) = x1; *(f32x4*)(xl + col) = x1; s2 += x1[0] * x1[0] + x1[1] * x1[1] + x1[2] * x1[2] + x1[3] * x1[3]; }
      if (donext) { s2 = wave_sum_l(s2, lane); const float r2 = rsqrtf(s2 * (1.0f / D) + EPS);
#pragma unroll 1
        for (int q = 0; q < 8; ++q) { const int col = q * 256 + lane * 4;
          const f32x4 h = *(const f32x4*)(xl + col) * r2 * *(const f32x4*)(gnext + col) * (*(const f32x4*)(mdn + (so + 1) * 2048 + col) + 1.0f) + *(const f32x4*)(mdn + so * 2048 + col);
          u32x2 hp; hp.x = cvt_pk_bf16(h[0], h[1]); hp.y = cvt_pk_bf16(h[2], h[3]); *(u32x2*)(H + (size_t)rw * D + col) = hp; } }
    }
  }
}

__device__ __forceinline__ void conv_item(const bf16_t* __restrict__ R, bf16_t* __restrict__ U, const float* __restrict__ cw, const float* __restrict__ cb, size_t it) {
  const int row = (int)(it >> 7), c8 = (int)(it & 127) * 8;
  int t, len; if (row < MLAT) { t = row & (SEQ - 1); len = SEQ; } else { t = (row - MLAT) & (CTXL - 1); len = CTXL; }
  float o[8]; uint4 rv[4];
#pragma unroll
  for (int k = 0; k < 4; ++k) { const int tt = t + k - 2; rv[k] = (tt >= 0 && tt < len) ? *(const uint4*)(R + (size_t)(row + k - 2) * 1024 + c8) : make_uint4(0u, 0u, 0u, 0u); }
  { const f32x4 b0 = *(const f32x4*)(cb + c8), b1 = *(const f32x4*)(cb + c8 + 4);
#pragma unroll
    for (int i = 0; i < 4; ++i) { o[i] = b0[i]; o[4 + i] = b1[i]; } }
#pragma unroll
  for (int k = 0; k < 4; ++k) { const f32x4 w0 = *(const f32x4*)(cw + k * 1024 + c8), w1 = *(const f32x4*)(cw + k * 1024 + c8 + 4); const unsigned rw[4] = {rv[k].x, rv[k].y, rv[k].z, rv[k].w};
    o[0] += w0[0] * bf_lo(rw[0]); o[1] += w0[1] * bf_hi(rw[0]); o[2] += w0[2] * bf_lo(rw[1]); o[3] += w0[3] * bf_hi(rw[1]);
    o[4] += w1[0] * bf_lo(rw[2]); o[5] += w1[1] * bf_hi(rw[2]); o[6] += w1[2] * bf_lo(rw[3]); o[7] += w1[3] * bf_hi(rw[3]); }
  uint4 w; w.x = cvt_pk_bf16(o[0], o[1]); w.y = cvt_pk_bf16(o[2], o[3]); w.z = cvt_pk_bf16(o[4], o[5]); w.w = cvt_pk_bf16(o[6], o[7]);
  *(uint4*)(U + (size_t)row * 1024 + c8) = w;
}
__device__ __forceinline__ void conv_item_slab(const float* __restrict__ FS, bf16_t* __restrict__ U, const float* __restrict__ cw, const float* __restrict__ cb, int rc, int c8) {
  const int t = rc & (CTXL - 1);
  f32x4 o0 = *(const f32x4*)(cb + c8), o1 = *(const f32x4*)(cb + c8 + 4);
#pragma unroll
  for (int k = 0; k < 4; ++k) { const int tt = t + k - 2;
    if (tt >= 0 && tt < CTXL) { const float* fp = FS + (size_t)(rc + k - 2) * 1024 + c8; f32x4 r0 = {0.f, 0.f, 0.f, 0.f}, r1 = r0;
#pragma unroll
      for (int sp = 0; sp < 4; ++sp) { r0 += *(const f32x4*)(fp + (size_t)sp * MCTX * 1024); r1 += *(const f32x4*)(fp + (size_t)sp * MCTX * 1024 + 4); }
      o0 += *(const f32x4*)(cw + k * 1024 + c8) * r0; o1 += *(const f32x4*)(cw + k * 1024 + c8 + 4) * r1; } }
  st8bf(U + (size_t)(MLAT + rc) * 1024 + c8, o0, o1);
}
__device__ __forceinline__ void phase_conv(const P& p, int l, bool ctx_from_slabs, int wvid) {
  const size_t gtid = (size_t)blockIdx.x * 512 + tid_fresh(wvid), nth = (size_t)gridDim.x * 512;
  const bf16_t* R = (const bf16_t*)(p.ws + OFF_R); bf16_t* U = (bf16_t*)(p.ws + OFF_U);
  const float* cw = p.conv_w + (size_t)l * 4 * 1024; const float* cb = p.conv_b + (size_t)l * 1024;
  const size_t nbf = (size_t)(ctx_from_slabs ? MLAT : MALL) * 128;
#pragma unroll 2
  for (size_t it = gtid; it < nbf; it += nth) conv_item(R, U, cw, cb, it);
  if (ctx_from_slabs) { const float* FS = (const float*)(p.ws + OFF_FS);
    for (size_t it = gtid; it < (size_t)MCTX * 128; it += nth) conv_item_slab(FS, U, cw, cb, (int)(it >> 7), (int)(it & 127) * 8); }
}
__device__ __forceinline__ void scan_item(size_t it, int& b, int& blk, int& pp, int& row0, int& cf, int& cb) {
  pp = (int)(it & 511); const int r = (int)(it >> 9); blk = r % NCH; b = r / NCH;
  if (blk < 8) { row0 = MLAT + b * CTXL + blk * 32; cf = blk; cb = 7 - blk; } else { const int kb = blk - 8; row0 = b * SEQ + kb * 32; cf = blk; cb = 8 + (255 - kb); }
}
__device__ __forceinline__ void phase_scan_sum(const P& p, int wvid) {
  const size_t gtid = (size_t)blockIdx.x * 512 + tid_fresh(wvid), nth = (size_t)gridDim.x * 512;
  const bf16_t* LA = (const bf16_t*)(p.ws + OFF_A); const bf16_t* BX = (const bf16_t*)(p.ws + OFF_BX);
  float* SA = (float*)(p.ws + OFF_SA); float* SH = (float*)(p.ws + OFF_SH);
  for (size_t it = gtid; it < (size_t)NB * NCH * 512; it += nth) {
    int b, blk, pp, row0, cf, cb; scan_item(it, b, blk, pp, row0, cf, cb);
    float s0 = 0.f, s1 = 0.f, h0 = 0.f, h1 = 0.f;
#pragma unroll 8
    for (int i = 0; i < 32; ++i) { const size_t o = (size_t)(row0 + i) * 2048 + 2 * pp; const unsigned lw = *(const unsigned*)(LA + o), bw = *(const unsigned*)(BX + o);
      const float l0 = bf_lo(lw), l1 = bf_hi(lw); s0 += l0; s1 += l1; h0 = __expf(l0) * h0 + bf_lo(bw); h1 = __expf(l1) * h1 + bf_hi(bw); }
    size_t so = ((size_t)(b * 2 + 0) * NCH + cf) * 1024 + 2 * pp; *(float2*)(SA + so) = make_float2(s0, s1); *(float2*)(SH + so) = make_float2(h0, h1);
    s0 = s1 = h0 = h1 = 0.f;
#pragma unroll 8
    for (int i = 31; i >= 0; --i) { const size_t o = (size_t)(row0 + i) * 2048 + 1024 + 2 * pp; const unsigned lw = *(const unsigned*)(LA + o), bw = *(const unsigned*)(BX + o);
      const float l0 = bf_lo(lw), l1 = bf_hi(lw); s0 += l0; s1 += l1; h0 = __expf(l0) * h0 + bf_lo(bw); h1 = __expf(l1) * h1 + bf_hi(bw); }
    so = ((size_t)(b * 2 + 1) * NCH + cb) * 1024 + 2 * pp; *(float2*)(SA + so) = make_float2(s0, s1); *(float2*)(SH + so) = make_float2(h0, h1);
  }
}
__device__ __forceinline__ void scan_carry_seq(const float* __restrict__ SA, const float* __restrict__ SH, float* __restrict__ CR) {
  float carry = 0.f;
#pragma unroll 1
  for (int c0 = 0; c0 < NCH; c0 += 24) {
    float a[24], h[24];
#pragma unroll
    for (int j = 0; j < 24; ++j) { a[j] = SA[(size_t)(c0 + j) * 1024]; h[j] = SH[(size_t)(c0 + j) * 1024]; }
#pragma unroll
    for (int j = 0; j < 24; ++j) { CR[(size_t)(c0 + j) * 1024] = carry; carry = __expf(a[j]) * carry + h[j]; }
  }
}
__device__ __forceinline__ void phase_scan_carry(const P& p, int wvid) {
  const size_t gtid = (size_t)blockIdx.x * 512 + tid_fresh(wvid);
  const int t = (int)(gtid & 511), wg = (int)(gtid >> 9);
  if (t >= 32) return;
  const int seq = wg * 32 + t; if (seq >= NB * 2 * 1024) return;
  const int ch = seq & 1023, bd = seq >> 10; const size_t o = (size_t)bd * NCH * 1024 + ch;
  scan_carry_seq((const float*)(p.ws + OFF_SA) + o, (const float*)(p.ws + OFF_SH) + o, (float*)(p.ws + OFF_CARRY) + o);
}
__device__ __forceinline__ void scan_fwd_item(const bf16_t* __restrict__ lp, const bf16_t* __restrict__ bp, float2* __restrict__ hfl, float h0, float h1) {
#pragma unroll
  for (int i0 = 0; i0 < 32; i0 += 8) { unsigned lw[8], bw[8];
#pragma unroll
    for (int j = 0; j < 8; ++j) { lw[j] = *(const unsigned*)(lp + (size_t)(i0 + j) * 2048); bw[j] = *(const unsigned*)(bp + (size_t)(i0 + j) * 2048); }
#pragma unroll
    for (int j = 0; j < 8; ++j) { h0 = __expf(bf_lo(lw[j])) * h0 + bf_lo(bw[j]); h1 = __expf(bf_hi(lw[j])) * h1 + bf_hi(bw[j]); hfl[(i0 + j) * 512] = make_float2(h0, h1); } }
}
__device__ __forceinline__ void scan_bwd_item(const bf16_t* __restrict__ lp, const bf16_t* __restrict__ bp, const bf16_t* __restrict__ gp, bf16_t* __restrict__ op, const float2* __restrict__ hfl, float h0, float h1) {
#pragma unroll
  for (int i0 = 24; i0 >= 0; i0 -= 8) { unsigned lw[8], bw[8], gw[8], ow[8];
#pragma unroll
    for (int j = 0; j < 8; ++j) { const int i = i0 + 7 - j; lw[j] = *(const unsigned*)(lp + (size_t)i * 2048); bw[j] = *(const unsigned*)(bp + (size_t)i * 2048); gw[j] = *(const unsigned*)(gp + (size_t)i * 1024); }
#pragma unroll
    for (int j = 0; j < 8; ++j) { const int i = i0 + 7 - j; h0 = __expf(bf_lo(lw[j])) * h0 + bf_lo(bw[j]); h1 = __expf(bf_hi(lw[j])) * h1 + bf_hi(bw[j]);
      const float2 hf = hfl[i * 512]; ow[j] = cvt_pk_bf16(bf_lo(gw[j]) * (hf.x + h0), bf_hi(gw[j]) * (hf.y + h1)); }
#pragma unroll
    for (int j = 0; j < 8; ++j) { const int i = i0 + 7 - j; *(unsigned*)(op + (size_t)i * 2048) = ow[j]; } }
}
__device__ __forceinline__ void phase_scan_final(const P& p, float2* hfl  , bool skip_ctx, int wvid) {
  const int tf = tid_fresh(wvid);
  const size_t gtid = (size_t)blockIdx.x * 512 + tf, nth = (size_t)gridDim.x * 512;
  const bf16_t* LA = (const bf16_t*)(p.ws + OFF_A); const bf16_t* BX = (const bf16_t*)(p.ws + OFF_BX); const bf16_t* GG = (const bf16_t*)(p.ws + OFF_GG);
  const float* CR = (const float*)(p.ws + OFF_CARRY); bf16_t* M2 = (bf16_t*)(p.ws + OFF_M2);
  for (size_t it = gtid; it < (size_t)NB * NCH * 512; it += nth) {
    int b, blk, pp, row0, cf, cb; scan_item(it, b, blk, pp, row0, cf, cb);
    if (skip_ctx && blk < 8) continue;
    const float2 c0 = *(const float2*)(CR + ((size_t)(b * 2 + 0) * NCH + cf) * 1024 + 2 * pp), c1 = *(const float2*)(CR + ((size_t)(b * 2 + 1) * NCH + cb) * 1024 + 2 * pp);
    scan_fwd_item(LA + (size_t)row0 * 2048 + 2 * pp, BX + (size_t)row0 * 2048 + 2 * pp, hfl + tf, c0.x, c0.y);
    scan_bwd_item(LA + (size_t)row0 * 2048 + 1024 + 2 * pp, BX + (size_t)row0 * 2048 + 1024 + 2 * pp, GG + (size_t)row0 * 1024 + 2 * pp,
                  M2 + (size_t)row0 * 2048 + 1024 + 2 * pp, hfl + tf, c1.x, c1.y);
  }
}

#ifndef TP
#define RUN(k) 1
#else
#define RUN(k) (TP == (k))
#endif
__global__ void __launch_bounds__(512, 2) fwd_megakernel(P p_unused) {
  extern __shared__ __attribute__((aligned(16))) unsigned char shm[];
  cg::grid_group grid = cg::this_grid();
  LAS unsigned char* lds = (LAS unsigned char*)shm;
  unsigned char* ws = load_p().ws;
  const char* wsc = (const char*)ws;
#define FRESH() do { ws = load_p().ws; asm volatile("" : "+s"(ws)); wsc = (const char*)ws; } while (0)
#define FRESHL() do { FRESH(); int l_ = l; asm volatile("" : "+s"(l_)); wl = wsc + OFF_W + (size_t)l_ * W_LAYER; } while (0)

  volatile LAS unsigned* xst = (volatile LAS unsigned*)(lds + STAGE_BYTES + TL_BYTES);
  const int wvid = __builtin_amdgcn_readfirstlane((int)threadIdx.x >> 6);
  if (threadIdx.x == 0) { xst[0] = 0u; xst[1] = 0u; xst[2] = 0u; xst[3] = 0u; }
  __syncthreads();
  const XcdBarrier xb = xcd_barrier_post((unsigned*)(load_p().ws + OFF_BAR), xst, (int)threadIdx.x);
#define GSYNC() do { XcdBarrier xb_ = xb; xb_.bar = (unsigned*)(load_p().ws + OFF_BAR); xcd_barrier(xb_, tid_fresh(wvid)); } while (0)
  if (RUN(0)) prep_a(load_p(), shm, wvid);
  if (load_p().ws == nullptr) grid.sync();
  GSYNC();
  {
    FRESH();
    if (RUN(1)) {
      GemmP g2{2048, 128 * 2048, 512, 128 * 512, 256}; gemm_phase(lds, g2, SchedFoldOut{ws}, EpiStore{ws, 2048}, wvid); }
    if (RUN(2)) { const int* MODI = (const int*)(ws + OFF_MOD); float* MODF = (float*)(ws + OFF_MODF); float* ml = (float*)shm; const int tq = tid_fresh(wvid);
      for (size_t i = (size_t)blockIdx.x * 512 + tq; i < (size_t)2 * 5 * 12288; i += (size_t)gridDim.x * 512) MODF[i] = (float)MODI[i] * FXI;
      for (int i = tq; i < 5 * 4096; i += 512) ml[i] = (float)MODI[(i >> 12) * 12288 + (i & 4095)] * FXI;
      __syncthreads();
      phase_e0(load_p(), ml, wvid); }
  }
  GSYNC();
  auto layer = [&](const int l) __attribute__((always_inline)) {
    const char* wl;
    const bool lastl = (l == DEPTH - 1); const int nrow = lastl ? MLAT : MALL, nMt = nrow / 256;
    FRESHL();
    if (RUN(3)) { GemmP g{4096, 128 * 4096, 4096, 128 * 4096, 2048};
      gemm_phase(lds, g, SchedReg{nMt, 12, wsc + OFF_H, wl + W_WINT, (size_t)256 * 4096, (size_t)256 * 4096},
                 EpiG1{(bf16_t*)(ws + OFF_BX), (bf16_t*)(ws + OFF_R), (bf16_t*)(ws + OFF_GG)}, wvid);
      if (!lastl) prep_late(load_p(), shm, wvid, 48);
      if (lastl) { GemmP gs{4096, 128 * 4096, 4096, 128 * 4096, 512};
        gemm_phase(lds, gs, SchedCtxSplitR{wsc + OFF_H, wl + W_WINT}, EpiSlabR{(float*)(ws + OFF_FS)}, wvid); } }
    GSYNC();
    FRESHL();
    { if (RUN(4)) { GemmP g{2048, 128 * 2048, 512, 128 * 512, 256};
        gemm_phase(lds, g, SchedDftCh{nMt, wsc + OFF_BX, wsc + OFF_CST}, EpiDftCh{(bf16_t*)(ws + OFF_A), (bf16_t*)(ws + OFF_H) + (size_t)MLAT * D, lds + STAGE_BYTES}, wvid); }
      if (RUN(6)) phase_conv(load_p(), l, lastl, wvid); }
    GSYNC();
    FRESHL();
    { if (RUN(4)) { GemmP g{262144, 512, 512, 128 * 512, 256}; gemm_phase(lds, g, SchedF2{wsc + OFF_A, wsc + OFF_D2}, EpiF2{(bf16_t*)(ws + OFF_H), lds + STAGE_BYTES}, wvid); }
 }
    GSYNC();
    FRESHL();
    { if (RUN(7)) { GemmP g{32768, 128 * 32768, 1024, 128 * 1024, 512}; gemm_phase(lds, g, SchedF3{wsc + OFF_H, wsc + OFF_D3}, EpiF3<false>{(bf16_t*)(ws + OFF_M2), lds + STAGE_BYTES}, wvid); }
      FRESHL();
      if (RUN(8)) { GemmP gg{2048, 128 * 2048, 512, 128 * 512, 256};
      gemm_phase(lds, gg, SchedGates{wsc + OFF_U, wl + W_WGT},
                 EpiGates{(const bf16_t*)(ws + OFF_U), (bf16_t*)(ws + OFF_A), (bf16_t*)(ws + OFF_BX), load_p().lru_b + (size_t)l * 4096, (const float*)(ws + OFF_SP8) + (size_t)l * 2048}, wvid); }
      FRESHL();
      if (RUN(5) && !lastl) { GemmP gc{1024, 128 * 1024, 1024, 128 * 1024, 512}; gemm_phase(lds, gc, SchedF2c{wsc + OFF_H + (size_t)MLAT * D * 2, wsc + OFF_DC}, EpiF3<true>{(bf16_t*)(ws + OFF_M2), lds + STAGE_BYTES}, wvid); } }
    GSYNC();
    FRESHL();
    if (RUN(9)) phase_scan_sum(load_p(), wvid);
    GSYNC();
    FRESHL();
    if (RUN(10)) phase_scan_carry(load_p(), wvid);
    GSYNC();
    FRESHL();
    if (RUN(11)) phase_scan_final(load_p(), (float2*)shm, lastl, wvid);
    GSYNC();
    FRESHL();
    if (RUN(12)) { GemmP g{4096, 128 * 4096, 4096, 128 * 4096, 2048};
      gemm_phase(lds, g, SchedReg{MLAT / 256, 8, wsc + OFF_M2, wl + W_WOUTT, (size_t)256 * 4096, (size_t)256 * 4096},
                 EpiYSS{(bf16_t*)(ws + OFF_A), (float*)(ws + OFF_RSSP)}, wvid);
      if (!lastl) { GemmP gs{4096, 128 * 4096, 4096, 128 * 4096, 512};
        gemm_phase(lds, gs, SchedCtxSplit{wsc + OFF_M2, wl + W_WOUTT, (size_t)256 * 4096, (size_t)256 * 4096, (size_t)512 * 2}, EpiSlab{(float*)(ws + OFF_FS)}, wvid); } }
    GSYNC();
    FRESHL();
    if (RUN(13)) phase_res(load_p(), l, 0, nrow, !lastl, wvid); if (!lastl) phase_res_ctx(load_p(), l, 0, (float*)shm, wvid);
    GSYNC();
    FRESHL();
    if (RUN(14)) { GemmP g{4096, 128 * 4096, 4096, 128 * 4096, 2048};
      gemm_phase(lds, g, SchedReg{nMt, 44, wsc + OFF_H, wl + W_WFFI, (size_t)256 * 4096, (size_t)256 * 4096}, EpiSwiGLU{(bf16_t*)(ws + OFF_ACT)}, wvid); }
    GSYNC();
    FRESHL();
    if (RUN(15)) { GemmP g{11264, 128 * 11264, 11264, 128 * 11264, DFF};
      gemm_phase(lds, g, SchedReg{MLAT / 256, 8, wsc + OFF_ACT, wl + W_WFFO, (size_t)256 * 11264, (size_t)256 * 11264},
                 EpiYSS{(bf16_t*)(ws + OFF_M2), (float*)(ws + OFF_RSSP)}, wvid);
      if (!lastl) { GemmP gs{11264, 128 * 11264, 11264, 128 * 11264, 1408};
        gemm_phase(lds, gs, SchedCtxSplit{wsc + OFF_ACT, wl + W_WFFO, (size_t)256 * 11264, (size_t)256 * 11264, (size_t)1408 * 2}, EpiSlab{(float*)(ws + OFF_FS)}, wvid); } }
    GSYNC();
    FRESHL();
    if (RUN(16)) phase_res(load_p(), l, 1, nrow, !lastl, wvid); if (!lastl) phase_res_ctx(load_p(), l, 1, (float*)shm, wvid);
    GSYNC();
  };
  layer(0);
  layer(1);
}

extern "C" void kernel_launch(void* const* d_in, const int* in_sizes, int n_in, void* d_out, int out_size,
                              void* d_ws, size_t ws_size, hipStream_t stream) {
  constexpr int LDS_BYTES = STAGE_BYTES + TL_BYTES + 16;
  static int grid = 0;
  if (!grid) {
    int dev = 0, cus = 0, per_cu = 0;
    (void)hipGetDevice(&dev);
    (void)hipDeviceGetAttribute(&cus, hipDeviceAttributeMultiprocessorCount, dev);
    (void)hipFuncSetAttribute((const void*)fwd_megakernel, hipFuncAttributeMaxDynamicSharedMemorySize, LDS_BYTES);
    (void)hipOccupancyMaxActiveBlocksPerMultiprocessor(&per_cu, (const void*)fwd_megakernel, 512, LDS_BYTES);
    grid = 256;
    fprintf(stderr, "cus %d per_cu %d grid %d ws_need %zu ws_have %zu\n", cus, per_cu, grid, (size_t)WS_END, ws_size);
  }
  if (ws_size < WS_END || n_in != 17) { fprintf(stderr, "kernel_launch: workspace too small or wrong inputs\n"); return; }
  (void)hipMemsetAsync(d_ws, 0, ZERO_BYTES, stream);
  P p{};
  p.x = (const float*)d_in[0]; p.c = (const float*)d_in[1]; p.ctx = (const float*)d_in[2]; p.c_ctx = (const float*)d_in[3];
  p.w_ada = (const float*)d_in[4]; p.b_ada = (const float*)d_in[5]; p.norm_g = (const float*)d_in[6]; p.w_in = (const float*)d_in[7];
  p.w_four = (const float*)d_in[8]; p.conv_w = (const float*)d_in[9]; p.conv_b = (const float*)d_in[10]; p.lru_w = (const float*)d_in[11];
  p.lru_b = (const float*)d_in[12]; p.lru_lam = (const float*)d_in[13]; p.w_out = (const float*)d_in[14]; p.w_ffn_in = (const float*)d_in[15];
  p.w_ffn_out = (const float*)d_in[16]; p.out = (float*)d_out; p.ws = (unsigned char*)d_ws;
  void* args[] = {&p};
  hipError_t e = hipLaunchCooperativeKernel((const void*)fwd_megakernel, dim3(grid), dim3(512), args, LDS_BYTES, stream);
  if (e != hipSuccess) fprintf(stderr, "cooperative launch failed: %s (grid %d)\n", hipGetErrorString(e), grid);
}
```

```cpp
#include <hip/hip_runtime.h>
#include <hip/hip_cooperative_groups.h>
#include <cstdio>
namespace cg = cooperative_groups;

#define LAS __attribute__((address_space(3)))
typedef unsigned short bf16_t;
typedef short bf16x8 __attribute__((ext_vector_type(8)));
typedef float f32x4 __attribute__((ext_vector_type(4)));
typedef unsigned u32x2 __attribute__((ext_vector_type(2)));
typedef float f32x2 __attribute__((ext_vector_type(2)));
typedef unsigned u32x4 __attribute__((ext_vector_type(4)));

constexpr int D = 2048, NB = 4, SEQ = 8192, CTXL = 256, DEPTH = 2;
constexpr int MLAT = NB * SEQ, MCTX = NB * CTXL, MALL = MLAT + MCTX;
constexpr int DFF = 5632, NCH = 264;
constexpr float EPS = 1e-6f, FX = 16777216.0f, FXI = 1.0f / 16777216.0f;

constexpr size_t AL(size_t x) { return (x + 255) & ~(size_t)255; }
constexpr size_t OFF_MOD = 0;
constexpr size_t OFF_RSS = OFF_MOD + (size_t)2 * 5 * 12288 * 4;
constexpr size_t OFF_BAR = OFF_RSS + (size_t)4 * MALL * 8;
constexpr size_t ZERO_BYTES = OFF_BAR + 3456 * 4;
constexpr size_t OFF_CST = AL(ZERO_BYTES);
constexpr size_t OFF_D2 = OFF_CST + 512 * 256 * 2;
constexpr size_t OFF_D3 = OFF_D2 + 256 * 256 * 2;
constexpr size_t OFF_DC = OFF_D3 + 256 * 512 * 2;
constexpr size_t OFF_SP8 = OFF_DC + 256 * 512 * 2;
constexpr size_t OFF_MODF = OFF_SP8 + 2 * 2 * 1024 * 4;
constexpr size_t OFF_W = OFF_MODF + (size_t)2 * 5 * 12288 * 4;
constexpr size_t W_WINT = 0;
constexpr size_t W_WINNAT = W_WINT + (size_t)4096 * 2048 * 2;
constexpr size_t W_WOUTT = W_WINNAT + (size_t)2048 * 1024 * 2;
constexpr size_t W_WOUTRAW = W_WOUTT + (size_t)2048 * 2048 * 2;
constexpr size_t W_WFNAT = W_WOUTRAW + (size_t)2048 * 1024 * 2;
constexpr size_t W_WGT = W_WFNAT + (size_t)4 * 256 * 256 * 2;
constexpr size_t W_WFFI = W_WGT + (size_t)4096 * 256 * 2;
constexpr size_t W_WFFO = W_WFFI + (size_t)11264 * 2048 * 2;
constexpr size_t W_LAYER = W_WFFO + (size_t)2048 * 5632 * 2;
constexpr size_t OFF_XC = OFF_W + 2 * W_LAYER;
constexpr size_t OFF_H = OFF_XC + (size_t)MCTX * D * 4;
constexpr size_t OFF_A = OFF_H + (size_t)MALL * D * 2;
constexpr size_t OFF_R = OFF_A + (size_t)MALL * D * 2;
constexpr size_t OFF_GG = OFF_R + (size_t)MALL * 1024 * 2;
constexpr size_t OFF_U = OFF_GG + (size_t)MALL * 1024 * 2;
constexpr size_t OFF_BX = OFF_U + (size_t)MALL * 1024 * 2;
constexpr size_t OFF_M2 = OFF_BX + (size_t)MALL * D * 2;
constexpr size_t OFF_SA = OFF_M2 + (size_t)MALL * D * 2;
constexpr size_t SZ_S = (size_t)NB * 2 * NCH * 1024 * 4;
constexpr size_t OFF_SH = OFF_SA + SZ_S;
constexpr size_t OFF_CARRY = OFF_SH + SZ_S;
constexpr size_t OFF_FS = OFF_CARRY + SZ_S;
constexpr size_t OFF_RSSP = OFF_FS + (size_t)4 * MCTX * D * 4;
constexpr size_t WS_END = OFF_RSSP + (size_t)MLAT * 32 * 4;
constexpr size_t OFF_ACT = OFF_A;
static_assert((size_t)MALL * DFF * 2 <= OFF_M2 - OFF_A, "ACT alias");

struct P {
  const float *x, *c, *ctx, *c_ctx, *w_ada, *b_ada, *norm_g, *w_in, *w_four, *conv_w, *conv_b, *lru_w, *lru_b, *lru_lam, *w_out, *w_ffn_in, *w_ffn_out;
  float* out; unsigned char* ws;
};

typedef const __attribute__((address_space(4))) P* KernArgP;
__device__ __forceinline__ P load_p() {
#if defined(__HIP_DEVICE_COMPILE__)
  KernArgP q = (KernArgP)__builtin_amdgcn_kernarg_segment_ptr(); asm volatile("" : "+s"(q));
  P r; r.x = q->x; r.c = q->c; r.ctx = q->ctx; r.c_ctx = q->c_ctx; r.w_ada = q->w_ada; r.b_ada = q->b_ada; r.norm_g = q->norm_g; r.w_in = q->w_in; r.w_four = q->w_four; r.conv_w = q->conv_w;
  r.conv_b = q->conv_b; r.lru_w = q->lru_w; r.lru_b = q->lru_b; r.lru_lam = q->lru_lam; r.w_out = q->w_out; r.w_ffn_in = q->w_ffn_in; r.w_ffn_out = q->w_ffn_out; r.out = q->out; r.ws = q->ws; return r;
#else
  return P{};
#endif
}

__device__ __forceinline__ unsigned cvt_pk_bf16(float lo, float hi) { unsigned r; asm volatile("v_cvt_pk_bf16_f32 %0, %1, %2" : "=v"(r) : "v"(lo), "v"(hi)); return r; }
__device__ __forceinline__ float bf_lo(unsigned w) { return __uint_as_float(w << 16); }
__device__ __forceinline__ float bf_hi(unsigned w) { return __uint_as_float(w & 0xffff0000u); }
__device__ __forceinline__ float wave_sum(float v) {
#pragma unroll
  for (int o = 32; o >= 1; o >>= 1) v += __shfl_xor(v, o);
  return v;
}
__device__ __forceinline__ float lane_xor(float v, int lane, int mask) { return __int_as_float(__builtin_amdgcn_ds_bpermute((lane ^ mask) << 2, __float_as_int(v))); }
__device__ __forceinline__ float wave_sum_l(float v, int lane) {
#pragma unroll
  for (int o = 32; o >= 1; o >>= 1) v += lane_xor(v, lane, o);
  return v;
}
__device__ __forceinline__ int tid_fresh(int wvid) { int t = wvid * 64 + (int)__builtin_amdgcn_mbcnt_hi(~0u, __builtin_amdgcn_mbcnt_lo(~0u, 0u)); asm volatile("" : "+v"(t)); return t; }
__device__ __forceinline__ float sigmoidf_(float v) { return __builtin_amdgcn_rcpf(1.0f + __builtin_amdgcn_exp2f(-1.4426950408889634f * v)); }
__device__ __forceinline__ f32x2 swiglu_pk(f32x2 g, f32x2 u) {
  const f32x2 t = g * -1.4426950408889634f; f32x2 e; e.x = __builtin_amdgcn_exp2f(t.x); e.y = __builtin_amdgcn_exp2f(t.y);
  const f32x2 d = e + 1.0f; f32x2 r; r.x = __builtin_amdgcn_rcpf(d.x); r.y = __builtin_amdgcn_rcpf(d.y);
  return (g * u) * r;
}
__device__ __forceinline__ f32x2 sigmoid_pk(f32x2 v) { const f32x2 t = v * -1.4426950408889634f; f32x2 e; e.x = __builtin_amdgcn_exp2f(t.x); e.y = __builtin_amdgcn_exp2f(t.y);
  const f32x2 d = e + 1.0f; f32x2 r; r.x = __builtin_amdgcn_rcpf(d.x); r.y = __builtin_amdgcn_rcpf(d.y); return r; }
__device__ __forceinline__ void gates_pk(f32x2 vr, f32x2 vi, f32x2 sp8, f32x2 u, f32x2& la, f32x2& bx) {
  const f32x2 rg = sigmoid_pk(vr), ig = sigmoid_pk(vi); la = -(rg * sp8);
  const f32x2 t = la * 2.8853900817779268f; f32x2 e; e.x = __builtin_amdgcn_exp2f(t.x); e.y = __builtin_amdgcn_exp2f(t.y);
  const f32x2 o = 1.0f - e; f32x2 q; q.x = __builtin_amdgcn_sqrtf(fmaxf(o.x, 0.f)); q.y = __builtin_amdgcn_sqrtf(fmaxf(o.y, 0.f));
  bx = q * (ig * u);
}
__device__ __forceinline__ float gelu_tanh(float v) { const float t = 0.7978845608028654f * (v + 0.044715f * v * v * v); return v * sigmoidf_(2.0f * t); }
__device__ __forceinline__ void st4bf(bf16_t* p, f32x4 v) { u32x2 w; w.x = cvt_pk_bf16(v[0], v[1]); w.y = cvt_pk_bf16(v[2], v[3]); *(u32x2*)p = w; }


#define XB_TMO      128
#define XB_XCNT(j)  (256  + 64 * (j))
#define XB_XSUB(j)  (1280 + 64 * (j))
#define XB_XGEN(j)  (2304 + 64 * (j))
#define XB_TOP      3328
#define XB_TOPGEN   3392
#define XB_SPIN_CAP (1u << 20)
__device__ __forceinline__ unsigned xb_ld(unsigned* p)              { return __hip_atomic_load(p, __ATOMIC_RELAXED, __HIP_MEMORY_SCOPE_AGENT); }
__device__ __forceinline__ unsigned xb_add(unsigned* p, unsigned v) { return __hip_atomic_fetch_add(p, v, __ATOMIC_RELAXED, __HIP_MEMORY_SCOPE_AGENT); }
__device__ __forceinline__ unsigned xb_xcc_id() { return (unsigned)__builtin_amdgcn_s_getreg((3 << 11) | 20) & 0xFu; }
#define XB_SPIN(cond, bar) do { unsigned _sp = 0; while (cond) { __builtin_amdgcn_s_sleep(1); \
    if ((++_sp & 255u) == 0u) { if (xb_ld(&(bar)[XB_TMO])) break; if (_sp > XB_SPIN_CAP) { atomicAdd(&(bar)[XB_TMO], 1u); break; } } } } while (0)
struct XcdBarrier { unsigned* bar; unsigned x; volatile LAS unsigned* st; };
__device__ __forceinline__ XcdBarrier xcd_barrier_post(unsigned* bar, volatile LAS unsigned* st, int tid) {
  XcdBarrier b; b.bar = bar; b.x = 0u; b.st = st;
  if (tid == 0) { const unsigned x = xb_xcc_id(); st[2] = x; (void)xb_add(&bar[XB_XCNT(x)], 1u); }
  return b;
}
__device__ __forceinline__ void xcd_barrier_complete(unsigned* bar, unsigned x, unsigned& nloc, unsigned& nx) {
  const unsigned G = gridDim.x * gridDim.y * gridDim.z;
  unsigned sum, cnt, mine, sp = 0u;
  for (;;) {
    sum = 0u; cnt = 0u; mine = 0u;
#pragma unroll
    for (unsigned j = 0; j < 16; ++j) { const unsigned c = xb_ld(&bar[XB_XCNT(j)]); sum += c; cnt += (c > 0u) ? 1u : 0u; mine = (j == x) ? c : mine; }
    if (sum == G) break;
    __builtin_amdgcn_s_sleep(1);
    if ((++sp & 255u) == 0u) { if (xb_ld(&bar[XB_TMO])) break; if (sp > XB_SPIN_CAP) { atomicAdd(&bar[XB_TMO], 1u); break; } }
  }
  nloc = mine > 0u ? mine : 1u; nx = cnt > 0u ? cnt : 1u;
}
__device__ __forceinline__ void xcd_barrier(const XcdBarrier& b, int tid) {
  asm volatile("s_waitcnt vmcnt(0)" ::: "memory");
  __syncthreads();
  if (tid == 0) {
    unsigned* bar = b.bar;
    __builtin_amdgcn_s_waitcnt(0);
    unsigned nloc = b.st[0], nx = b.st[1]; const unsigned bx = __builtin_amdgcn_readfirstlane(b.st[2]);
    if (nloc == 0u) { xcd_barrier_complete(bar, bx, nloc, nx); b.st[0] = nloc; b.st[1] = nx; }
    const unsigned old = xb_add(&bar[XB_XSUB(bx)], 1u);
    const unsigned gen = old / nloc;
    if (old + 1u == (gen + 1u) * nloc) {
      __builtin_amdgcn_fence(__ATOMIC_RELEASE, "agent");
      asm volatile("s_waitcnt vmcnt(0)" ::: "memory");
      const unsigned og = xb_add(&bar[XB_TOP], 1u);
      const unsigned tg = og / nx;
      if (og + 1u == (tg + 1u) * nx) xb_add(&bar[XB_TOPGEN], 1u);
      else XB_SPIN(xb_ld(&bar[XB_TOPGEN]) == tg, bar);
      __builtin_amdgcn_fence(__ATOMIC_ACQUIRE, "agent");
      xb_add(&bar[XB_XGEN(bx)], 1u);
      asm volatile("s_waitcnt vmcnt(0)" ::: "memory");
    } else {
      XB_SPIN(xb_ld(&bar[XB_XGEN(bx)]) == gen, bar);
      __builtin_amdgcn_fence(__ATOMIC_ACQUIRE, "agent");
      asm volatile("s_waitcnt vmcnt(0)" ::: "memory");
    }
  }
  __syncthreads();
}

constexpr int BM = 256, BK = 64, HALF = 128, HTB = HALF * BK * 2, STAGE_BYTES = 8 * HTB, NXCD = 8, WGM = 4;
__device__ __forceinline__ int lds_byte(int r, int c) { const int st = (r >> 4) * 2 + (c >> 5), rr = r & 15, cc = c & 31, ob = rr * 64 + cc * 2; return st * 1024 + (ob ^ (((ob >> 9) & 1) << 5)); }
__device__ __forceinline__ void stage_rc(int b, int& R, int& C) { const int st = b / 1024, sb = b % 1024, swz = sb ^ (((sb >> 9) & 1) << 5); R = (st >> 1) * 16 + swz / 64; C = (st & 1) * 32 + (swz % 64) / 2; }

__device__ __forceinline__ int perm32(int rho) { const int n = rho >> 4, i = rho & 15; return 8 * (i >> 2) + 4 * n + (i & 3); }
struct Unit { int pm, pn; const char* a; const char* b; size_t o; };
struct GemmP { unsigned lda2, ahs, ldb2, bhs; int K; };

__device__ __forceinline__ bool grid_order(int i, int nM, int nN, int& pm, int& pn) {
  const int nwg = nM * nN; const long L = (long)i * gridDim.x + blockIdx.x; if (L >= nwg) return false;
  int wgid = (int)L; { const int q = nwg / NXCD, r = nwg % NXCD, xcd = wgid % NXCD, off = wgid / NXCD; wgid = (xcd < r ? xcd * (q + 1) : r * (q + 1) + (xcd - r) * q) + off; }
  const int nig = WGM * nN, gid = wgid / nig, fm = gid * WGM, gsz = (nM - fm) < WGM ? (nM - fm) : WGM;
  pm = fm + ((wgid % nig) % gsz); pn = (wgid % nig) / gsz; return true;
}

template <class Epi, class Sched>
__device__ __forceinline__ void gemm_phase(LAS unsigned char* lds, const GemmP g, const Sched& S, const Epi& E, int wvid) {
  int tid = tid_fresh(wvid);
  const int wid = __builtin_amdgcn_readfirstlane(tid >> 6), lane = tid & 63, wr = wid >> 2, wc = wid & 3, fr = lane & 15, fq = lane >> 4;
  int Kop = g.K; asm volatile("" : "+s"(Kop));
  const int nt = Kop / BK;
  unsigned voffA[2], voffB[2];
#pragma unroll
  for (int i = 0; i < 2; ++i) { int R, C; stage_rc(tid * 16 + i * 8192, R, C); const int Rb = Epi::PERM ? ((R & ~31) + perm32(R & 31)) : R;
    voffA[i] = (unsigned)R * g.lda2 + (unsigned)C * 2u; voffB[i] = (unsigned)Rb * g.ldb2 + (unsigned)C * 2u; }
  const size_t kstep = (size_t)(BK * 2);
  const size_t ahs = g.ahs, bhs = g.bhs;
  const unsigned ldsw = (unsigned)wid * 1024u;
  const int aoff = lds_byte(wr * 64 + fr, fq * 8), boff = lds_byte(wc * 32 + fr, fq * 8);
#define PG8_SA(b, h) (((b) * 2 + (h)) * HTB)
#define PG8_SB(b, h) ((4 + (b) * 2 + (h)) * HTB)
#define PG8_STAGE(bufoff, gbase, voff) do { _Pragma("unroll") for (int _i = 0; _i < 2; ++_i) \
    __builtin_amdgcn_global_load_lds((const unsigned*)((const char*)(gbase) + (voff)[_i]), (LAS unsigned*)(lds + (bufoff) + ldsw + _i * 8192), 16, 0, 0); } while (0)
#define PG8_LDA(dst, b, h) do { _Pragma("unroll") for (int m = 0; m < 4; ++m) _Pragma("unroll") for (int k = 0; k < 2; ++k) dst[m][k] = *(const LAS bf16x8*)(lds + PG8_SA(b, h) + aoff + m * 2048 + k * 1024); } while (0)
#define PG8_LDB(dst, b, h) do { _Pragma("unroll") for (int n = 0; n < 2; ++n) _Pragma("unroll") for (int k = 0; k < 2; ++k) dst[n][k] = *(const LAS bf16x8*)(lds + PG8_SB(b, h) + boff + n * 2048 + k * 1024); } while (0)
#define PG8_MMA(ai, bj, At, Bt) do { __builtin_amdgcn_s_setprio(1); _Pragma("unroll") for (int m = 0; m < 4; ++m) _Pragma("unroll") for (int n = 0; n < 2; ++n) _Pragma("unroll") for (int k = 0; k < 2; ++k) \
    acc[ai][bj][m][n] = __builtin_amdgcn_mfma_f32_16x16x32_bf16(Bt[n][k], At[m][k], acc[ai][bj][m][n], 0, 0, 0); __builtin_amdgcn_s_setprio(0); } while (0)
#define PG8_WAIT_V(n) asm volatile("s_waitcnt vmcnt(" #n ")" ::: "memory")
#define PG8_WAIT_L(n) asm volatile("s_waitcnt lgkmcnt(" #n ")" ::: "memory")
#define PG8_BAR __builtin_amdgcn_s_barrier()
#define PG8_SCHED __builtin_amdgcn_sched_barrier(0)
  Unit cur, nxt; int ui = 0;
  if (!S.next(0, cur)) return;
  f32x4 acc[2][2][4][2];
#pragma unroll
  for (int a = 0; a < 2; ++a)
#pragma unroll
    for (int b = 0; b < 2; ++b)
#pragma unroll
      for (int m = 0; m < 4; ++m)
#pragma unroll
        for (int n = 0; n < 2; ++n) acc[a][b][m][n] = (f32x4){0.f, 0.f, 0.f, 0.f};
  bf16x8 At[4][2], B0[2][2], B1[2][2];
  const char* cA = cur.a; const char* cB = cur.b;
  asm volatile("" : "+s"(cA), "+s"(cB));
  PG8_STAGE(PG8_SB(0, 0), cB, voffB); PG8_STAGE(PG8_SA(0, 0), cA, voffA); PG8_STAGE(PG8_SB(0, 1), cB + bhs, voffB); PG8_STAGE(PG8_SA(0, 1), cA + ahs, voffA);
  if (wr == 1) PG8_BAR;
  PG8_WAIT_V(4); PG8_BAR;
  PG8_STAGE(PG8_SB(1, 0), cB + kstep, voffB); PG8_STAGE(PG8_SA(1, 0), cA + kstep, voffA); PG8_STAGE(PG8_SB(1, 1), cB + bhs + kstep, voffB);
  PG8_WAIT_V(6); PG8_BAR;
  for (;;) {
    const bool has_next = S.next(ui + 1, nxt);
    const char* nA = has_next ? nxt.a : cA; const char* nB = has_next ? nxt.b : cB;
    asm volatile("" : "+s"(nA), "+s"(nB));
    for (int t = 0; t < nt; t += 2) {
      const bool last = (t == nt - 2);
      const char* a1 = cA + (size_t)(t + 1) * kstep;
      const char* a2 = last ? nA : cA + (size_t)(t + 2) * kstep; const char* b2 = last ? nB : cB + (size_t)(t + 2) * kstep;
      const char* a3 = a2 + kstep; const char* b3 = b2 + kstep;
      PG8_LDB(B0, 0, 0); PG8_SCHED; PG8_LDA(At, 0, 0); PG8_STAGE(PG8_SA(1, 1), a1 + ahs, voffA);
      PG8_WAIT_L(8); PG8_BAR; PG8_WAIT_L(0); PG8_MMA(0, 0, At, B0); PG8_BAR; PG8_SCHED;
      PG8_LDB(B1, 0, 1); PG8_STAGE(PG8_SB(0, 0), b2, voffB);
      PG8_BAR; PG8_WAIT_L(0); PG8_MMA(0, 1, At, B1); PG8_BAR;
      PG8_LDA(At, 0, 1); PG8_STAGE(PG8_SA(0, 0), a2, voffA);
      PG8_BAR; PG8_WAIT_L(0); PG8_MMA(1, 0, At, B0); PG8_BAR; PG8_SCHED;
      PG8_STAGE(PG8_SB(0, 1), b2 + bhs, voffB);
      PG8_WAIT_V(6); PG8_BAR; PG8_MMA(1, 1, At, B1); PG8_BAR;
      PG8_LDB(B0, 1, 0); PG8_SCHED; PG8_LDA(At, 1, 0); PG8_STAGE(PG8_SA(0, 1), a2 + ahs, voffA);
      PG8_WAIT_L(8); PG8_BAR; PG8_WAIT_L(0); PG8_MMA(0, 0, At, B0); PG8_BAR; PG8_SCHED;
      PG8_LDB(B1, 1, 1); PG8_STAGE(PG8_SB(1, 0), b3, voffB);
      PG8_BAR; PG8_WAIT_L(0); PG8_MMA(0, 1, At, B1); PG8_BAR;
      PG8_LDA(At, 1, 1); PG8_STAGE(PG8_SA(1, 0), a3, voffA);
      PG8_BAR; PG8_WAIT_L(0); PG8_MMA(1, 0, At, B0); PG8_BAR; PG8_SCHED;
      PG8_STAGE(PG8_SB(1, 1), b3 + bhs, voffB);
      PG8_WAIT_V(6); PG8_BAR; PG8_MMA(1, 1, At, B1); PG8_BAR;
    }
    E(acc, cur, wr, wc, fr, fq);
    if (!has_next) break;
#pragma unroll
    for (int a = 0; a < 2; ++a)
#pragma unroll
      for (int b = 0; b < 2; ++b)
#pragma unroll
        for (int m = 0; m < 4; ++m)
#pragma unroll
          for (int n = 0; n < 2; ++n) acc[a][b][m][n] = (f32x4){0.f, 0.f, 0.f, 0.f};
    cur = nxt; cA = nA; cB = nB; ++ui;
  }
  PG8_WAIT_V(0);
  if (wr == 0) PG8_BAR;
  PG8_BAR;
#undef PG8_SA
#undef PG8_SB
#undef PG8_STAGE
#undef PG8_LDA
#undef PG8_LDB
#undef PG8_MMA
#undef PG8_WAIT_V
#undef PG8_WAIT_L
#undef PG8_BAR
#undef PG8_SCHED
}

#define EPI_ARGS const f32x4 (&acc)[2][2][4][2], const Unit& u, int wr, int wc, int fr, int fq
#define FOR_AM _Pragma("unroll") for (int ai = 0; ai < 2; ++ai) _Pragma("unroll") for (int m = 0; m < 4; ++m)
#define FOR_BN _Pragma("unroll") for (int bj = 0; bj < 2; ++bj) _Pragma("unroll") for (int n = 0; n < 2; ++n)

constexpr int TL_WAVE_BYTES = 16 * 80 * 2, TL_BYTES = 8 * TL_WAVE_BYTES;
template <class F>
__device__ __forceinline__ void wave_tstore(const f32x4& a0, const f32x4& a1, const f32x4& a2, const f32x4& a3, LAS bf16_t* tl, int fr, int fq, int lane, F colptr) {
  const f32x4 av[4] = {a0, a1, a2, a3};
#pragma unroll
  for (int m = 0; m < 4; ++m) { const unsigned w0 = cvt_pk_bf16(av[m][0], av[m][1]), w1 = cvt_pk_bf16(av[m][2], av[m][3]); LAS bf16_t* q = tl + (4 * fq) * 80 + 16 * m + fr;
    q[0] = (bf16_t)(w0 & 0xffffu); q[80] = (bf16_t)(w0 >> 16); q[160] = (bf16_t)(w1 & 0xffffu); q[240] = (bf16_t)(w1 >> 16); }
#pragma unroll
  for (int ps = 0; ps < 2; ++ps) { const int c = (lane >> 3) + 8 * ps; const u32x4 w = *(const LAS u32x4*)(tl + c * 80 + (lane & 7) * 8); *(u32x4*)(colptr(c) + (lane & 7) * 8) = w; }
}

struct SchedReg {
  int nM, nN; const char* A; const char* B; size_t atile, btile;
  __device__ __forceinline__ bool next(int i, Unit& u) const { int pm, pn; if (!grid_order(i, nM, nN, pm, pn)) return false; u.pm = pm; u.pn = pn; u.a = A + (size_t)pm * atile; u.b = B + (size_t)pn * btile; u.o = 0; return true; }
};
struct SchedCtxSplit {
  const char* A; const char* B; size_t atile, btile, kbytes;
  __device__ __forceinline__ bool next(int i, Unit& u) const { const int L = i * (int)gridDim.x + (int)blockIdx.x; if (L >= 128) return false;
    const int sp = L & 3, t = L >> 2, pn = t & 7, pmc = t >> 3; u.pm = pmc; u.pn = pn; u.o = (size_t)sp;
    u.a = A + (size_t)(MLAT / 256 + pmc) * atile + (size_t)sp * kbytes; u.b = B + (size_t)pn * btile + (size_t)sp * kbytes; return true; }
};
struct SchedDftCh {
  int nM; const char* A; const char* B;
  __device__ __forceinline__ bool next(int i, Unit& u) const { int pm, pn; if (!grid_order(i, nM, 8, pm, pn)) return false; u.pm = pm; u.pn = pn;
    u.a = A + (size_t)pm * (256 * 1024 * 2) + (size_t)(pn >> 1) * 512; u.b = B + (size_t)(pn & 1) * (256 * 256 * 2); u.o = 0; return true; }
};
struct SchedCtxSplitR {
  const char* A; const char* B;
  __device__ __forceinline__ bool next(int i, Unit& u) const { const int L = i * (int)gridDim.x + (int)blockIdx.x; if (L >= 64) return false;
    const int sp = L & 3, t = L >> 2, pnr = t & 3, pmc = t >> 2; u.pm = pmc; u.pn = pnr; u.o = (size_t)sp;
    u.a = A + (size_t)(MLAT / 256 + pmc) * (256 * 4096) + (size_t)sp * 1024; u.b = B + (size_t)(4 + pnr) * (256 * 4096) + (size_t)sp * 1024; return true; }
};
struct SchedGates {
  const char* A; const char* B;
  __device__ __forceinline__ bool next(int i, Unit& u) const { int pm, pn; if (!grid_order(i, MALL / 256, 16, pm, pn)) return false; u.pm = pm; u.pn = pn;
    u.a = A + (size_t)pm * (256 * 1024 * 2) + (size_t)((pn >> 1) & 3) * 512; u.b = B + (size_t)pn * (256 * 256 * 2); u.o = 0; return true; }
};
struct SchedFoldIn {
  const unsigned char* ws;
  __device__ __forceinline__ bool next(int i, Unit& u) const { if (i > 0) return false; const int L = blockIdx.x; if (L >= 128) return false;
    const int l = L >> 6, g = (L >> 4) & 3, pm = (L >> 3) & 1, pn = L & 7; u.pm = pm; u.pn = pn;
    u.a = (const char*)ws + OFF_CST + (size_t)pm * (256 * 256 * 2);
    u.b = (const char*)ws + OFF_W + l * W_LAYER + W_WINNAT + ((size_t)pn * 256 * 1024 + g * 256) * 2;
    u.o = OFF_W + l * W_LAYER + W_WINT + ((size_t)(g * 512 + pm * 256) * 2048 + pn * 256) * 2; return true; }
};
struct SchedFoldOut {
  const unsigned char* ws;
  __device__ __forceinline__ bool next(int i, Unit& u) const { if (i > 0) return false; const int L = (int)blockIdx.x - 128; if (L < 0 || L >= 64) return false;
    const int l = L >> 5, g = (L >> 3) & 3, pm = L & 7; u.pm = pm; u.pn = 0;
    u.a = (const char*)ws + OFF_W + l * W_LAYER + W_WOUTRAW + ((size_t)pm * 256 * 1024 + g * 256) * 2;
    u.b = (const char*)ws + OFF_W + l * W_LAYER + W_WFNAT + (size_t)g * 65536 * 2;
    u.o = OFF_W + l * W_LAYER + W_WOUTT + ((size_t)(pm * 256) * 2048 + g * 256) * 2; return true; }
};
struct SchedF2 {
  const char* P1; const char* D2m;
  __device__ __forceinline__ bool next(int i, Unit& u) const { const int L = i * (int)gridDim.x + (int)blockIdx.x; if (L >= 1024) return false;
    const int b = L >> 8, g = (L >> 6) & 3, j = L & 63; u.pm = b * 4 + g; u.pn = j;
    u.a = P1 + ((size_t)((b * 128) * 4 + g) * 256 + 4 * j) * 128 * 2; u.b = D2m; u.o = 0; return true; }
};
struct SchedF3 {
  const char* Q; const char* D3m;
  __device__ __forceinline__ bool next(int i, Unit& u) const { const int L = i * (int)gridDim.x + (int)blockIdx.x; if (L >= 512) return false;
    const int b = L >> 7, g = (L >> 5) & 3, e = L & 31; u.pm = b * 4 + g; u.pn = e;
    u.a = Q + ((size_t)((b * 4 + g) * 256) * 64 + 2 * e) * 256 * 2; u.b = D3m; u.o = 0; return true; }
};
struct SchedF2c {
  const char* P1c; const char* DCm;
  __device__ __forceinline__ bool next(int i, Unit& u) const { if (i > 0) return false; const int L = (int)gridDim.x - 1 - (int)blockIdx.x; if (L >= 16) return false;
    u.pm = L; u.pn = 0; u.a = P1c + (size_t)(L * 256) * 512 * 2; u.b = DCm; u.o = 0; return true; }
};

struct EpiStore {
  static constexpr bool PERM = false;
  unsigned char* ws; int ldc;
  __device__ __forceinline__ void operator()(EPI_ARGS) const {
    bf16_t* base = (bf16_t*)(ws + u.o);
    FOR_AM { const int rr = 128 * ai + 64 * wr + 16 * m + fr;
      FOR_BN st4bf(base + (size_t)rr * ldc + 128 * bj + 32 * wc + 16 * n + 4 * fq, acc[ai][bj][m][n]); asm volatile("" ::: "memory"); }
  }
};
__device__ __forceinline__ void st8bf(bf16_t* p, f32x4 v0, f32x4 v1) { u32x4 w; w.x = cvt_pk_bf16(v0[0], v0[1]); w.y = cvt_pk_bf16(v0[2], v0[3]); w.z = cvt_pk_bf16(v1[0], v1[1]); w.w = cvt_pk_bf16(v1[2], v1[3]); *(u32x4*)p = w; }
struct EpiG1 {
  static constexpr bool PERM = true;
  bf16_t* FB; bf16_t* R; bf16_t* GG;
  __device__ __forceinline__ void operator()(EPI_ARGS) const {
    const int pm = u.pm, pn = u.pn;
    if (pn < 8) {
      bf16_t* dst = pn < 4 ? FB + pn * 256 : R + (pn - 4) * 256;
      FOR_AM { const int rr = 128 * ai + 64 * wr + 16 * m + fr; bf16_t* rowp = dst + (size_t)(pm * 256 + rr) * 1024 + 32 * wc + 8 * fq;
        st8bf(rowp, acc[ai][0][m][0], acc[ai][0][m][1]); st8bf(rowp + 128, acc[ai][1][m][0], acc[ai][1][m][1]); }
    } else {
      FOR_AM { const int rr = 128 * ai + 64 * wr + 16 * m + fr; bf16_t* rowp = GG + (size_t)(pm * 256 + rr) * 1024 + (pn - 8) * 256 + 32 * wc + 8 * fq;
#pragma unroll
        for (int bj = 0; bj < 2; ++bj) { f32x4 v0 = acc[ai][bj][m][0], v1 = acc[ai][bj][m][1];
#pragma unroll
          for (int i = 0; i < 4; ++i) { v0[i] = gelu_tanh(v0[i]); v1[i] = gelu_tanh(v1[i]); }
          st8bf(rowp + 128 * bj, v0, v1); }
        }
    }
  }
};
struct EpiDftCh {
  static constexpr bool PERM = false;
  bf16_t* P1; bf16_t* P1c; LAS unsigned char* tlb;
  __device__ __forceinline__ void operator()(EPI_ARGS) const {
    const int pm = u.pm, pn = u.pn;
    const int g = pn >> 1, ri = pn & 1, lane = fr + 16 * fq; LAS bf16_t* tl = (LAS bf16_t*)(tlb + (wr * 4 + wc) * TL_WAVE_BYTES);
#pragma unroll
    for (int ai = 0; ai < 2; ++ai) {
      bf16_t* rowp; int ks;
      if (pm < 128) { const int b = pm >> 5, n1 = 4 * (pm & 31) + 2 * ai + wr; rowp = P1 + ((size_t)((b * 128 + n1) * 4 + g) * 256 * 2 + ri) * 64; ks = 128; }
      else { const int b = pm - 128; rowp = P1c + ((size_t)((b * 4 + g) * 256) * 2 + ri) * 256 + 128 * ai + 64 * wr; ks = 512; }
      FOR_BN { const int k30 = 128 * bj + 32 * wc + 16 * n;
        wave_tstore(acc[ai][bj][0][n], acc[ai][bj][1][n], acc[ai][bj][2][n], acc[ai][bj][3][n], tl, fr, fq, lane, [&](int c) { return rowp + (size_t)(k30 + c) * ks; }); }
      asm volatile("" ::: "memory"); }
  }
};
struct EpiF2 {
  static constexpr bool PERM = false;
  bf16_t* Q; LAS unsigned char* tlb;
  __device__ __forceinline__ void operator()(EPI_ARGS) const {
    const int bg = u.pm, j = u.pn, rip = wc >> 1, lane = fr + 16 * fq; LAS bf16_t* tl = (LAS bf16_t*)(tlb + (wr * 4 + wc) * TL_WAVE_BYTES);
#pragma unroll
    for (int ai = 0; ai < 2; ++ai) {
      FOR_BN { const int k3 = 4 * j + 2 * ai + bj, k20 = 32 * (wc & 1) + 16 * n;
        bf16_t* base = Q + (((size_t)(bg * 256 + k3) * 64 + k20) * 2 + rip) * 128 + 64 * wr;
        wave_tstore(acc[ai][bj][0][n], acc[ai][bj][1][n], acc[ai][bj][2][n], acc[ai][bj][3][n], tl, fr, fq, lane, [&](int c) { return base + (size_t)c * 256; }); }
      asm volatile("" ::: "memory"); }
  }
};
template <bool CTX> struct EpiF3 {
  static constexpr bool PERM = false;
  bf16_t* M2; LAS unsigned char* tlb;
  __device__ __forceinline__ void operator()(EPI_ARGS) const {
    const int b = u.pm >> 2, g = u.pm & 3, e = u.pn, lane = fr + 16 * fq; LAS bf16_t* tl = (LAS bf16_t*)(tlb + (wr * 4 + wc) * TL_WAVE_BYTES);
#pragma unroll
    for (int ai = 0; ai < 2; ++ai) {
      FOR_BN { size_t tok0, tstep;
        if (CTX) { tok0 = (size_t)MLAT + b * 256 + (128 * bj + 32 * wc + 16 * n); tstep = 1; }
        else { const int k10 = 32 * wc + 16 * n, k2 = 2 * e + bj; tok0 = (size_t)b * SEQ + k10 * 64 + k2; tstep = 64; }
        bf16_t* base = M2 + tok0 * D + g * 256 + 128 * ai + 64 * wr; const size_t ts = tstep * D;
        wave_tstore(acc[ai][bj][0][n], acc[ai][bj][1][n], acc[ai][bj][2][n], acc[ai][bj][3][n], tl, fr, fq, lane, [&](int c) { return base + (size_t)c * ts; }); }
      asm volatile("" ::: "memory"); }
  }
};
struct EpiGates {
  static constexpr bool PERM = true;
  const bf16_t* U; bf16_t* LA; bf16_t* BX; const float* lb; const float* sp8t;
  __device__ __forceinline__ void operator()(EPI_ARGS) const {
    const int pm = u.pm, pn = u.pn, d = pn >> 3, h = (pn >> 1) & 3, half = pn & 1;
    const int ch = h * 256 + half * 128 + 32 * wc + 8 * fq;
    const size_t rowb = (size_t)pm * 256 + 64 * wr + fr;
    u32x4 uu[2][4]; f32x4 br[2], bi[2], sp8[2];
#pragma unroll
    for (int n = 0; n < 2; ++n) { br[n] = *(const f32x4*)(lb + (d * 2 + 0) * 1024 + ch + 4 * n); bi[n] = *(const f32x4*)(lb + (d * 2 + 1) * 1024 + ch + 4 * n); sp8[n] = *(const f32x4*)(sp8t + d * 1024 + ch + 4 * n); }
    FOR_AM uu[ai][m] = *(const u32x4*)(U + (rowb + 128 * ai + 16 * m) * 1024 + ch);
    FOR_AM { const size_t row = rowb + 128 * ai + 16 * m; const u32x4 uw = uu[ai][m];
      const float uv[2][4] = {{bf_lo(uw.x), bf_hi(uw.x), bf_lo(uw.y), bf_hi(uw.y)}, {bf_lo(uw.z), bf_hi(uw.z), bf_lo(uw.w), bf_hi(uw.w)}};
      f32x4 la[2], bx[2];
#pragma unroll
      for (int n = 0; n < 2; ++n)
#pragma unroll
        for (int hh = 0; hh < 2; ++hh) { const int i0 = 2 * hh; f32x2 l2, b2;
          gates_pk((f32x2){acc[ai][0][m][n][i0] + br[n][i0], acc[ai][0][m][n][i0 + 1] + br[n][i0 + 1]}, (f32x2){acc[ai][1][m][n][i0] + bi[n][i0], acc[ai][1][m][n][i0 + 1] + bi[n][i0 + 1]},
                   (f32x2){sp8[n][i0], sp8[n][i0 + 1]}, (f32x2){uv[n][i0], uv[n][i0 + 1]}, l2, b2);
          la[n][i0] = l2.x; la[n][i0 + 1] = l2.y; bx[n][i0] = b2.x; bx[n][i0 + 1] = b2.y; }
      st8bf(LA + row * 2048 + d * 1024 + ch, la[0], la[1]); st8bf(BX + row * 2048 + d * 1024 + ch, bx[0], bx[1]); }
  }
};
struct EpiSlab {
  static constexpr bool PERM = false;
  float* FS;
  __device__ __forceinline__ void operator()(EPI_ARGS) const {
    FOR_AM { float* rowp = FS + ((size_t)u.o * MCTX + u.pm * 256 + 128 * ai + 64 * wr + 16 * m + fr) * D + u.pn * 256;
      FOR_BN *(f32x4*)(rowp + 128 * bj + 32 * wc + 16 * n + 4 * fq) = acc[ai][bj][m][n]; asm volatile("" ::: "memory"); }
  }
};
struct EpiSlabR {
  static constexpr bool PERM = false;
  float* FS;
  __device__ __forceinline__ void operator()(EPI_ARGS) const {
    FOR_AM { float* rowp = FS + ((size_t)u.o * MCTX + u.pm * 256 + 128 * ai + 64 * wr + 16 * m + fr) * 1024 + u.pn * 256;
      FOR_BN *(f32x4*)(rowp + 128 * bj + 32 * wc + 16 * n + 4 * fq) = acc[ai][bj][m][n]; asm volatile("" ::: "memory"); }
  }
};
struct EpiYSS {
  static constexpr bool PERM = true;
  bf16_t* Y; float* rssp;
  __device__ __forceinline__ void operator()(EPI_ARGS) const {
    FOR_AM { const size_t row = (size_t)u.pm * 256 + 128 * ai + 64 * wr + 16 * m + fr; float s = 0.f;
      FOR_BN { const f32x4 v = acc[ai][bj][m][n]; s += v[0] * v[0] + v[1] * v[1] + v[2] * v[2] + v[3] * v[3]; }
      bf16_t* rowp = Y + row * D + u.pn * 256 + 32 * wc + 8 * fq;
      st8bf(rowp, acc[ai][0][m][0], acc[ai][0][m][1]); st8bf(rowp + 128, acc[ai][1][m][0], acc[ai][1][m][1]);
      s += __shfl_xor(s, 16); s += __shfl_xor(s, 32);
      if (fq == 0) rssp[row * 32 + u.pn * 4 + wc] = s; }
  }
};
struct EpiSwiGLU {
  static constexpr bool PERM = true;
  bf16_t* ACT;
  __device__ __forceinline__ void operator()(EPI_ARGS) const {
    FOR_AM { const size_t row = (size_t)u.pm * 256 + 128 * ai + 64 * wr + 16 * m + fr; f32x4 o0, o1;
      { const f32x4 g0 = acc[ai][0][m][0], g1 = acc[ai][0][m][1], u0 = acc[ai][1][m][0], u1 = acc[ai][1][m][1];
        const f32x2 a = swiglu_pk((f32x2){g0[0], g0[1]}, (f32x2){u0[0], u0[1]}), b = swiglu_pk((f32x2){g0[2], g0[3]}, (f32x2){u0[2], u0[3]});
        const f32x2 c = swiglu_pk((f32x2){g1[0], g1[1]}, (f32x2){u1[0], u1[1]}), d = swiglu_pk((f32x2){g1[2], g1[3]}, (f32x2){u1[2], u1[3]});
        o0 = (f32x4){a.x, a.y, b.x, b.y}; o1 = (f32x4){c.x, c.y, d.x, d.y}; }
      st8bf(ACT + row * DFF + u.pn * 128 + 32 * wc + 8 * fq, o0, o1); }
  }
};

template <class F>
__device__ __forceinline__ void transpose_job(const float* __restrict__ src, int srcld, int K, int NR, bf16_t* __restrict__ dst, int dstld, F off, float* tile, int& tbase, int tid, int G, int cwg) {
  const int nkt = K / 64, ntile = nkt * (NR / 64);
  int t = (cwg - tbase % G + G) % G;
  float r[8];
  if (t < ntile) { const int k0 = (t % nkt) * 64, r0 = (t / nkt) * 64;
#pragma unroll
    for (int e = 0; e < 8; ++e) { const int idx = tid + 512 * e, kk = idx >> 6, nn = idx & 63; r[e] = src[(size_t)off(r0 + nn) + (size_t)(k0 + kk) * srcld]; } }
  for (; t < ntile; t += G) {
    const int k0 = (t % nkt) * 64, r0 = (t / nkt) * 64, tn = t + G; float rn[8];
    if (tn < ntile) { const int k1 = (tn % nkt) * 64, r1 = (tn / nkt) * 64;
#pragma unroll
      for (int e = 0; e < 8; ++e) { const int idx = tid + 512 * e, kk = idx >> 6, nn = idx & 63; rn[e] = src[(size_t)off(r1 + nn) + (size_t)(k1 + kk) * srcld]; } }
#pragma unroll
    for (int e = 0; e < 8; ++e) { const int idx = tid + 512 * e, kk = idx >> 6, nn = idx & 63; tile[kk * 65 + nn] = r[e]; }
    __syncthreads();
#pragma unroll
    for (int e = 0; e < 4; ++e) { const int idx = tid + 512 * e, nn = idx >> 5, kp = idx & 31;
      *(unsigned*)(dst + (size_t)(r0 + nn) * dstld + k0 + 2 * kp) = cvt_pk_bf16(tile[(2 * kp) * 65 + nn], tile[(2 * kp + 1) * 65 + nn]); }
    __syncthreads();
#pragma unroll
    for (int e = 0; e < 8; ++e) r[e] = rn[e];
  }
  tbase += ntile;
}
struct OffId { int add; __device__ __forceinline__ size_t operator()(int r) const { return (size_t)(r + add); } };
struct OffGates { __device__ __forceinline__ size_t operator()(int r) const { const int pn = r >> 8, d = pn >> 3, h = (pn >> 1) & 3, half = pn & 1, w = r & 255, gate = w >> 7;
  return (size_t)(((d * 2 + gate) * 4 + h)) * 65536 + half * 128 + (w & 127); } };
struct OffSwi { __device__ __forceinline__ size_t operator()(int r) const { const int pn = r >> 8, w = r & 255; return (size_t)(w >> 7) * DFF + pn * 128 + (w & 127); } };

__device__ __forceinline__ void prep_a(const P& p, unsigned char* shm, int wvid) {
  const int tid = tid_fresh(wvid);
  const size_t gtid = (size_t)blockIdx.x * 512 + tid, nth = (size_t)gridDim.x * 512;
  unsigned char* ws = p.ws;
  { bf16_t* CST = (bf16_t*)(ws + OFF_CST); bf16_t* D2m = (bf16_t*)(ws + OFF_D2); bf16_t* D3m = (bf16_t*)(ws + OFF_D3); bf16_t* DCm = (bf16_t*)(ws + OFF_DC);
    for (size_t i = gtid; i < 512 * 256; i += nth) { const int j = (int)(i >> 8), c = (int)(i & 255), t = (c * (j & 255)) & 255; const float ang = (float)t * (2.0f / 256.0f);
      const float v = (j < 256 ? cospif(ang) : -sinpif(ang)) * (1.0f / 16.0f); CST[i] = (bf16_t)(cvt_pk_bf16(v, 0.f) & 0xffffu); }
    for (size_t i = gtid; i < 256 * 256; i += nth) { const int np = (int)(i >> 8), k = (int)(i & 255), parp = np >> 7, rip = (np >> 6) & 1, k2 = np & 63, par = k >> 7, ri = (k >> 6) & 1, n2 = k & 63;
      const float ang = (float)((k2 * n2) & 63) * (2.0f / 64.0f), cs = cospif(ang) * 0.125f, sn = sinpif(ang) * 0.125f;
      const float v = par != parp ? 0.f : (rip == 0 ? (ri == 0 ? cs : sn) : (ri == 0 ? -sn : cs)); D2m[i] = (bf16_t)(cvt_pk_bf16(v, 0.f) & 0xffffu); }
    for (size_t i = gtid; i < 256 * 512; i += nth) { const int np = (int)(i >> 9), k = (int)(i & 511), qp = np >> 7, k1 = np & 127, q = k >> 8, ri = (k >> 7) & 1, n1 = k & 127;
      const float ang = (float)((k1 * n1) & 127) * (2.0f / 128.0f); const float v = q != qp ? 0.f : (ri == 0 ? cospif(ang) : sinpif(ang)) * 0.08838834764831845f;
      D3m[i] = (bf16_t)(cvt_pk_bf16(v, 0.f) & 0xffffu); }
    for (size_t i = gtid; i < 256 * 512; i += nth) { const int kp = (int)(i >> 9), k = (int)(i & 511), ri = k >> 8, t = k & 255;
      const float ang = (float)((kp * t) & 255) * (2.0f / 256.0f); const float v = (ri == 0 ? cospif(ang) : sinpif(ang)) * (1.0f / 16.0f);
      DCm[i] = (bf16_t)(cvt_pk_bf16(v, 0.f) & 0xffffu); } }
  { float* SP8 = (float*)(ws + OFF_SP8); for (size_t i = gtid; i < 4096; i += nth) SP8[i] = 8.0f * log1pf(__expf(-p.lru_lam[i])); }
  for (size_t i = gtid; i < (size_t)2 * 65536; i += nth) { const int l = (int)(i >> 16), r = (int)(i & 65535);
    const f32x4 v = *(const f32x4*)(p.w_four + (size_t)l * 262144 + r * 4); st4bf((bf16_t*)(ws + OFF_W + l * W_LAYER + W_WFNAT) + r * 4, v); }
  float* tile = (float*)shm; int tbase = 0; const int G = gridDim.x, cwg = blockIdx.x;
  for (int l = 0; l < DEPTH; ++l) {
    unsigned char* wl = ws + OFF_W + l * W_LAYER;
    if (l == 0) {
      transpose_job(p.w_ffn_in + (size_t)l * 2048 * 11264, 11264, 2048, 11264, (bf16_t*)(wl + W_WFFI), 2048, OffSwi{}, tile, tbase, tid, G, cwg);
      transpose_job(p.w_ffn_out + (size_t)l * DFF * 2048, 2048, DFF, 2048, (bf16_t*)(wl + W_WFFO), DFF, OffId{0}, tile, tbase, tid, G, cwg);
      transpose_job(p.w_in + (size_t)l * 2048 * 3072, 3072, 2048, 3072, (bf16_t*)(wl + W_WINT), 2048, OffId{0}, tile, tbase, tid, G, cwg);
      transpose_job(p.lru_w + (size_t)l * 16 * 65536, 256, 256, 4096, (bf16_t*)(wl + W_WGT), 256, OffGates{}, tile, tbase, tid, G, cwg); }
    transpose_job(p.w_out + (size_t)l * 2048 * 2048, 2048, 1024, 2048, (bf16_t*)(wl + W_WOUTRAW), 1024, OffId{0}, tile, tbase, tid, G, cwg);
    transpose_job(p.w_out + (size_t)l * 2048 * 2048 + (size_t)1024 * 2048, 2048, 1024, 2048, (bf16_t*)(wl + W_WOUTT) + 1024, 2048, OffId{0}, tile, tbase, tid, G, cwg);
  }
  float* sl = (float*)shm;
  __syncthreads();
  for (int i = tid; i < 5 * 2048; i += 512) { const int r = i >> 11, dd = i & 2047; const float cv = r < 4 ? p.c[r * 2048 + dd] : p.c_ctx[dd]; sl[i] = cv * sigmoidf_(cv); }
  __syncthreads();
  for (size_t it = gtid; it < (size_t)2 * 3072 * 32; it += nth) {
    const int cgp = (int)(it % 3072), rest = (int)(it / 3072), kc = rest & 31, l = rest >> 5;
    f32x4 a0 = {0.f, 0.f, 0.f, 0.f}, a1 = a0, a2 = a0, a3 = a0, a4 = a0;
    const float* wp = p.w_ada + ((size_t)l * 2048 + kc * 64) * 12288 + cgp * 4;
#pragma unroll 8
    for (int dd = 0; dd < 64; ++dd) { const f32x4 w = *(const f32x4*)(wp + (size_t)dd * 12288); const int d0 = kc * 64 + dd;
      a0 += sl[d0] * w; a1 += sl[2048 + d0] * w; a2 += sl[4096 + d0] * w; a3 += sl[6144 + d0] * w; a4 += sl[8192 + d0] * w; }
    if (kc == 0) { const f32x4 bb = *(const f32x4*)(p.b_ada + (size_t)l * 12288 + cgp * 4); a0 += bb; a1 += bb; a2 += bb; a3 += bb; a4 += bb; }
    int* mp = (int*)(ws + OFF_MOD) + (size_t)l * 5 * 12288 + cgp * 4;
#pragma unroll
    for (int j = 0; j < 4; ++j) { atomicAdd(mp + j, __float2int_rn(a0[j] * FX)); atomicAdd(mp + 12288 + j, __float2int_rn(a1[j] * FX)); atomicAdd(mp + 2 * 12288 + j, __float2int_rn(a2[j] * FX));
      atomicAdd(mp + 3 * 12288 + j, __float2int_rn(a3[j] * FX)); atomicAdd(mp + 4 * 12288 + j, __float2int_rn(a4[j] * FX)); }
  }
}

__device__ __forceinline__ void prep_late(const P& p, unsigned char* shm, int wvid, int first_idle) {
  const int cwg = (int)blockIdx.x - first_idle, G = (int)gridDim.x - first_idle; if (cwg < 0) return;
  const int tid = tid_fresh(wvid); float* tile = (float*)shm; int tbase = 0; const int l = 1; unsigned char* wl = p.ws + OFF_W + l * W_LAYER;
  transpose_job(p.w_ffn_in + (size_t)l * 2048 * 11264, 11264, 2048, 11264, (bf16_t*)(wl + W_WFFI), 2048, OffSwi{}, tile, tbase, tid, G, cwg);
  transpose_job(p.w_ffn_out + (size_t)l * DFF * 2048, 2048, DFF, 2048, (bf16_t*)(wl + W_WFFO), DFF, OffId{0}, tile, tbase, tid, G, cwg);
  transpose_job(p.w_in + (size_t)l * 2048 * 3072, 3072, 2048, 3072, (bf16_t*)(wl + W_WINT), 2048, OffId{0}, tile, tbase, tid, G, cwg);
  transpose_job(p.lru_w + (size_t)l * 16 * 65536, 256, 256, 4096, (bf16_t*)(wl + W_WGT), 256, OffGates{}, tile, tbase, tid, G, cwg);
}

__device__ __forceinline__ float* xrow(const P& p, int row) { return (float*)(p.ws + OFF_XC) + (size_t)(row - MLAT) * D; }
__device__ __forceinline__ const float* xin_row(const P& p, int row) { return row < MLAT ? p.x + (size_t)row * D : p.ctx + (size_t)(row - MLAT) * D; }

__device__ __forceinline__ void norm_mod_store(const f32x4 (&v)[8], const float* __restrict__ g, const float* __restrict__ shift, const float* __restrict__ scale, bf16_t* __restrict__ hrow, int lane) {
  float ss = 0.f;
#pragma unroll
  for (int q = 0; q < 8; ++q) ss += v[q][0] * v[q][0] + v[q][1] * v[q][1] + v[q][2] * v[q][2] + v[q][3] * v[q][3];
  ss = wave_sum(ss); const float rstd = rsqrtf(ss * (1.0f / D) + EPS);
  u32x2 hp[8];
#pragma unroll
  for (int q = 0; q < 8; ++q) { const int col = q * 256 + lane * 4; const f32x4 gg = *(const f32x4*)(g + col), sc = *(const f32x4*)(scale + col), sh = *(const f32x4*)(shift + col);
    f32x4 h;
#pragma unroll
    for (int i = 0; i < 4; ++i) h[i] = v[q][i] * rstd * gg[i] * (1.0f + sc[i]) + sh[i];
    hp[q].x = cvt_pk_bf16(h[0], h[1]); hp[q].y = cvt_pk_bf16(h[2], h[3]); }
#pragma unroll
  for (int q = 0; q < 8; ++q) *(u32x2*)(hrow + q * 256 + lane * 4) = hp[q];
}
__device__ __forceinline__ void norm_mod_store_r(const f32x4 (&v)[8], const f32x4 (&gb)[8], const f32x4 (&gc)[8], bf16_t* __restrict__ hrow, int lane) {
  float ss = 0.f;
#pragma unroll
  for (int q = 0; q < 8; ++q) ss += v[q][0] * v[q][0] + v[q][1] * v[q][1] + v[q][2] * v[q][2] + v[q][3] * v[q][3];
  ss = wave_sum(ss); const float rstd = rsqrtf(ss * (1.0f / D) + EPS);
  u32x2 hp[8];
#pragma unroll
  for (int q = 0; q < 8; ++q) { const f32x4 h = v[q] * rstd * gb[q] + gc[q]; hp[q].x = cvt_pk_bf16(h[0], h[1]); hp[q].y = cvt_pk_bf16(h[2], h[3]); }
#pragma unroll
  for (int q = 0; q < 8; ++q) *(u32x2*)(hrow + q * 256 + lane * 4) = hp[q];
}
__device__ __forceinline__ void phase_e0(const P& p, const float* MOD  , int wvid) {
  const int tf = tid_fresh(wvid), lane = tf & 63, wv = blockIdx.x * 8 + (tf >> 6), nwv = gridDim.x * 8;
  bf16_t* H = (bf16_t*)(p.ws + OFF_H);
  if (nwv == 2048) {
    const int bb = wv & 3, r0 = bb * SEQ + (wv >> 2); const float* md = MOD + (size_t)bb * 4096;
    f32x4 gb[8], gc[8];
#pragma unroll
    for (int q = 0; q < 8; ++q) { const int col = q * 256 + lane * 4; gb[q] = *(const f32x4*)(p.norm_g + col) * (*(const f32x4*)(md + 2048 + col) + 1.0f); gc[q] = *(const f32x4*)(md + col); }
    f32x4 v[8];
#pragma unroll
    for (int q = 0; q < 8; ++q) v[q] = *(const f32x4*)(p.x + (size_t)r0 * D + q * 256 + lane * 4);
#pragma unroll 1
    for (int k = 0; k < 16; ++k) { const int row = r0 + 512 * k; f32x4 vn[8];
      if (k < 15) {
#pragma unroll
        for (int q = 0; q < 8; ++q) vn[q] = *(const f32x4*)(p.x + (size_t)(row + 512) * D + q * 256 + lane * 4); }
      norm_mod_store_r(v, gb, gc, H + (size_t)row * D, lane);
#pragma unroll
      for (int q = 0; q < 8; ++q) v[q] = vn[q]; }
    for (int row = MLAT + wv; row < MALL; row += nwv) { const float* src = xin_row(p, row); const float* mdc = MOD + (size_t)4 * 4096; f32x4 vc[8];
#pragma unroll
      for (int q = 0; q < 8; ++q) vc[q] = *(const f32x4*)(src + q * 256 + lane * 4);
      norm_mod_store(vc, p.norm_g, mdc, mdc + 2048, H + (size_t)row * D, lane); }
    return;
  }
  for (int row = wv; row < MALL; row += nwv) { const float* src = xin_row(p, row); const int mr = row < MLAT ? row / SEQ : 4; const float* md = MOD + (size_t)mr * 4096; f32x4 v[8];
#pragma unroll
    for (int q = 0; q < 8; ++q) v[q] = *(const f32x4*)(src + q * 256 + lane * 4);
    norm_mod_store(v, p.norm_g, md, md + 2048, H + (size_t)row * D, lane); }
}
__device__ __forceinline__ void phase_res(const P& p, int l, int which  , int nrows, bool ctx_slabs, int wvid) {
  const int tf = tid_fresh(wvid), lane = tf & 63, wv = blockIdx.x * 8 + (tf >> 6), nwv = gridDim.x * 8;
  const float* MOD = (const float*)(p.ws + OFF_MODF); bf16_t* H = (bf16_t*)(p.ws + OFF_H);
  const bf16_t* Y = (const bf16_t*)(p.ws + (which == 0 ? OFF_A : OFF_M2));
  const float* rssp = (const float*)(p.ws + OFF_RSSP) + (lane & 31);
  const float* gpost = p.norm_g + (size_t)(l * 4 + (which == 0 ? 1 : 3)) * D;
  const bool donext = (which == 0) || (l + 1 < DEPTH);
  const int ln = which == 0 ? l : l + 1;
  const float* gnext = p.norm_g + (size_t)(ln * 4 + (which == 0 ? 2 : 0)) * D;
  const bool from_in = (l == 0 && which == 0);
  const int so = which == 0 ? 3 : 0;
  {
    const int bb = wv & 3, r0 = bb * SEQ + (wv >> 2); const float* md = MOD + ((size_t)l * 5 + bb) * 12288; const float* mdn = MOD + ((size_t)ln * 5 + bb) * 12288;
    bf16_t* XB = (bf16_t*)p.out; const bool final_out = !donext;
    f32x4 ga[8], gb[8], gc[8];
#pragma unroll
    for (int q = 0; q < 8; ++q) { const int col = q * 256 + lane * 4; ga[q] = *(const f32x4*)(gpost + col) * *(const f32x4*)(md + (which == 0 ? 2 : 5) * 2048 + col);
      if (donext) { gb[q] = *(const f32x4*)(gnext + col) * (*(const f32x4*)(mdn + (so + 1) * 2048 + col) + 1.0f); gc[q] = *(const f32x4*)(mdn + so * 2048 + col); } }
    f32x4 v[8]; u32x2 xx[8], yy[8]; float rs;
#pragma unroll
    for (int q = 0; q < 8; ++q) { const int col = q * 256 + lane * 4; yy[q] = *(const u32x2*)(Y + (size_t)r0 * D + col);
      if (from_in) v[q] = *(const f32x4*)(p.x + (size_t)r0 * D + col); else xx[q] = *(const u32x2*)(XB + (size_t)r0 * (2 * D) + col); }
    rs = lane < 32 ? rssp[(size_t)r0 * 32] : 0.f;
#pragma unroll 1
    for (int k = 0; k < 16; ++k) { const int row = r0 + 512 * k; f32x4 vn[8]; u32x2 xn[8], yn[8]; float rsn = 0.f;
      if (k < 15) { const int nx = row + 512;
#pragma unroll
        for (int q = 0; q < 8; ++q) { const int col = q * 256 + lane * 4; yn[q] = *(const u32x2*)(Y + (size_t)nx * D + col);
          if (from_in) vn[q] = *(const f32x4*)(p.x + (size_t)nx * D + col); else xn[q] = *(const u32x2*)(XB + (size_t)nx * (2 * D) + col); }
        rsn = lane < 32 ? rssp[(size_t)nx * 32] : 0.f; }
      const float rstd = rsqrtf(wave_sum(rs) * (1.0f / D) + EPS);
#pragma unroll
      for (int q = 0; q < 8; ++q) { const f32x4 yv = {bf_lo(yy[q].x), bf_hi(yy[q].x), bf_lo(yy[q].y), bf_hi(yy[q].y)};
        if (!from_in) v[q] = (f32x4){bf_lo(xx[q].x), bf_hi(xx[q].x), bf_lo(xx[q].y), bf_hi(xx[q].y)};
        v[q] = v[q] + yv * rstd * ga[q]; }
      if (final_out) {
#pragma unroll
        for (int q = 0; q < 8; ++q) *(f32x4*)(p.out + (size_t)row * D + q * 256 + lane * 4) = v[q];
      } else {
#pragma unroll
        for (int q = 0; q < 8; ++q) { u32x2 xo; xo.x = cvt_pk_bf16(v[q][0], v[q][1]); xo.y = cvt_pk_bf16(v[q][2], v[q][3]); *(u32x2*)(XB + (size_t)row * (2 * D) + q * 256 + lane * 4) = xo; }
        norm_mod_store_r(v, gb, gc, H + (size_t)row * D, lane); }
#pragma unroll
      for (int q = 0; q < 8; ++q) { if (from_in) v[q] = vn[q]; else xx[q] = xn[q]; yy[q] = yn[q]; }
      rs = rsn; }
  }
}
__device__ __forceinline__ void phase_res_ctx(const P& p, int l, int which, float* xlds  , int wvid) {
  const int tf = tid_fresh(wvid), lane = tf & 63, wv = blockIdx.x * 8 + (tf >> 6), nwv = gridDim.x * 8;
  const float* MOD = (const float*)(p.ws + OFF_MODF); bf16_t* H = (bf16_t*)(p.ws + OFF_H);
  const float* gpost = p.norm_g + (size_t)(l * 4 + (which == 0 ? 1 : 3)) * D;
  const bool donext = (which == 0) || (l + 1 < DEPTH);
  const int ln = which == 0 ? l : l + 1;
  const float* gnext = p.norm_g + (size_t)(ln * 4 + (which == 0 ? 2 : 0)) * D;
  const bool from_in = (l == 0 && which == 0);
  const int so = which == 0 ? 3 : 0;
  {
    const float* FS = (const float*)(p.ws + OFF_FS); float* xl = xlds + (tf >> 6) * 2048;
    const float* md = MOD + ((size_t)l * 5 + 4) * 12288; const float* gate = md + (which == 0 ? 2 : 5) * 2048; const float* mdn = MOD + ((size_t)ln * 5 + 4) * 12288;
#pragma unroll 1
    for (int rc = wv; rc < MCTX; rc += nwv) { const int rw = MLAT + rc;
      const float* src = from_in ? xin_row(p, rw) : xrow(p, rw); float* dstx = xrow(p, rw); const float* fp0 = FS + (size_t)rc * D + lane * 4;
      float ss = 0.f;
#pragma unroll 1
      for (int q = 0; q < 8; ++q) { const float* fp = fp0 + q * 256;
        const f32x4 y = *(const f32x4*)fp + *(const f32x4*)(fp + (size_t)MCTX * D) + *(const f32x4*)(fp + (size_t)2 * MCTX * D) + *(const f32x4*)(fp + (size_t)3 * MCTX * D);
        ss += y[0] * y[0] + y[1] * y[1] + y[2] * y[2] + y[3] * y[3]; }
      ss = wave_sum_l(ss, lane); const float rstd = rsqrtf(ss * (1.0f / D) + EPS); float s2 = 0.f;
#pragma unroll 1
      for (int q = 0; q < 8; ++q) { const int col = q * 256 + lane * 4; const float* fp = fp0 + q * 256;
        const f32x4 y = *(const f32x4*)fp + *(const f32x4*)(fp + (size_t)MCTX * D) + *(const f32x4*)(fp + (size_t)2 * MCTX * D) + *(const f32x4*)(fp + (size_t)3 * MCTX * D);
        const f32x4 x1 = *(const f32x4*)(src + col) + *(const f32x4*)(gate + col) * (y * rstd * *(const f32x4*)(gpost + col));
        *(f32x4*)(dstx + col) = x1; *(f32x4*)(xl + col) = x1; s2 += x1[0] * x1[0] + x1[1] * x1[1] + x1[2] * x1[2] + x1[3] * x1[3]; }
      if (donext) { s2 = wave_sum_l(s2, lane); const float r2 = rsqrtf(s2 * (1.0f / D) + EPS);
#pragma unroll 1
        for (int q = 0; q < 8; ++q) { const int col = q * 256 + lane * 4;
          const f32x4 h = *(const f32x4*)(xl + col) * r2 * *(const f32x4*)(gnext + col) * (*(const f32x4*)(mdn + (so + 1) * 2048 + col) + 1.0f) + *(const f32x4*)(mdn + so * 2048 + col);
          u32x2 hp; hp.x = cvt_pk_bf16(h[0], h[1]); hp.y = cvt_pk_bf16(h[2], h[3]); *(u32x2*)(H + (size_t)rw * D + col) = hp; } }
    }
  }
}

__device__ __forceinline__ void conv_item(const bf16_t* __restrict__ R, bf16_t* __restrict__ U, const float* __restrict__ cw, const float* __restrict__ cb, size_t it) {
  const int row = (int)(it >> 7), c8 = (int)(it & 127) * 8;
  int t, len; if (row < MLAT) { t = row & (SEQ - 1); len = SEQ; } else { t = (row - MLAT) & (CTXL - 1); len = CTXL; }
  float o[8]; uint4 rv[4];
#pragma unroll
  for (int k = 0; k < 4; ++k) { const int tt = t + k - 2; rv[k] = (tt >= 0 && tt < len) ? *(const uint4*)(R + (size_t)(row + k - 2) * 1024 + c8) : make_uint4(0u, 0u, 0u, 0u); }
  { const f32x4 b0 = *(const f32x4*)(cb + c8), b1 = *(const f32x4*)(cb + c8 + 4);
#pragma unroll
    for (int i = 0; i < 4; ++i) { o[i] = b0[i]; o[4 + i] = b1[i]; } }
#pragma unroll
  for (int k = 0; k < 4; ++k) { const f32x4 w0 = *(const f32x4*)(cw + k * 1024 + c8), w1 = *(const f32x4*)(cw + k * 1024 + c8 + 4); const unsigned rw[4] = {rv[k].x, rv[k].y, rv[k].z, rv[k].w};
    o[0] += w0[0] * bf_lo(rw[0]); o[1] += w0[1] * bf_hi(rw[0]); o[2] += w0[2] * bf_lo(rw[1]); o[3] += w0[3] * bf_hi(rw[1]);
    o[4] += w1[0] * bf_lo(rw[2]); o[5] += w1[1] * bf_hi(rw[2]); o[6] += w1[2] * bf_lo(rw[3]); o[7] += w1[3] * bf_hi(rw[3]); }
  uint4 w; w.x = cvt_pk_bf16(o[0], o[1]); w.y = cvt_pk_bf16(o[2], o[3]); w.z = cvt_pk_bf16(o[4], o[5]); w.w = cvt_pk_bf16(o[6], o[7]);
  *(uint4*)(U + (size_t)row * 1024 + c8) = w;
}
__device__ __forceinline__ void conv_item_slab(const float* __restrict__ FS, bf16_t* __restrict__ U, const float* __restrict__ cw, const float* __restrict__ cb, int rc, int c8) {
  const int t = rc & (CTXL - 1);
  f32x4 o0 = *(const f32x4*)(cb + c8), o1 = *(const f32x4*)(cb + c8 + 4);
#pragma unroll
  for (int k = 0; k < 4; ++k) { const int tt = t + k - 2;
    if (tt >= 0 && tt < CTXL) { const float* fp = FS + (size_t)(rc + k - 2) * 1024 + c8; f32x4 r0 = {0.f, 0.f, 0.f, 0.f}, r1 = r0;
#pragma unroll
      for (int sp = 0; sp < 4; ++sp) { r0 += *(const f32x4*)(fp + (size_t)sp * MCTX * 1024); r1 += *(const f32x4*)(fp + (size_t)sp * MCTX * 1024 + 4); }
      o0 += *(const f32x4*)(cw + k * 1024 + c8) * r0; o1 += *(const f32x4*)(cw + k * 1024 + c8 + 4) * r1; } }
  st8bf(U + (size_t)(MLAT + rc) * 1024 + c8, o0, o1);
}
__device__ __forceinline__ void phase_conv(const P& p, int l, bool ctx_from_slabs, int wvid) {
  const size_t gtid = (size_t)blockIdx.x * 512 + tid_fresh(wvid), nth = (size_t)gridDim.x * 512;
  const bf16_t* R = (const bf16_t*)(p.ws + OFF_R); bf16_t* U = (bf16_t*)(p.ws + OFF_U);
  const float* cw = p.conv_w + (size_t)l * 4 * 1024; const float* cb = p.conv_b + (size_t)l * 1024;
  const size_t nbf = (size_t)(ctx_from_slabs ? MLAT : MALL) * 128;
#pragma unroll 2
  for (size_t it = gtid; it < nbf; it += nth) conv_item(R, U, cw, cb, it);
  if (ctx_from_slabs) { const float* FS = (const float*)(p.ws + OFF_FS);
    for (size_t it = gtid; it < (size_t)MCTX * 128; it += nth) conv_item_slab(FS, U, cw, cb, (int)(it >> 7), (int)(it & 127) * 8); }
}
__device__ __forceinline__ void scan_item(size_t it, int& b, int& blk, int& pp, int& row0, int& cf, int& cb) {
  pp = (int)(it & 511); const int r = (int)(it >> 9); blk = r % NCH; b = r / NCH;
  if (blk < 8) { row0 = MLAT + b * CTXL + blk * 32; cf = blk; cb = 7 - blk; } else { const int kb = blk - 8; row0 = b * SEQ + kb * 32; cf = blk; cb = 8 + (255 - kb); }
}
__device__ __forceinline__ void phase_scan_sum(const P& p, int wvid) {
  const size_t gtid = (size_t)blockIdx.x * 512 + tid_fresh(wvid), nth = (size_t)gridDim.x * 512;
  const bf16_t* LA = (const bf16_t*)(p.ws + OFF_A); const bf16_t* BX = (const bf16_t*)(p.ws + OFF_BX);
  float* SA = (float*)(p.ws + OFF_SA); float* SH = (float*)(p.ws + OFF_SH);
  for (size_t it = gtid; it < (size_t)NB * NCH * 512; it += nth) {
    int b, blk, pp, row0, cf, cb; scan_item(it, b, blk, pp, row0, cf, cb);
    float s0 = 0.f, s1 = 0.f, h0 = 0.f, h1 = 0.f;
#pragma unroll 8
    for (int i = 0; i < 32; ++i) { const size_t o = (size_t)(row0 + i) * 2048 + 2 * pp; const unsigned lw = *(const unsigned*)(LA + o), bw = *(const unsigned*)(BX + o);
      const float l0 = bf_lo(lw), l1 = bf_hi(lw); s0 += l0; s1 += l1; h0 = __expf(l0) * h0 + bf_lo(bw); h1 = __expf(l1) * h1 + bf_hi(bw); }
    size_t so = ((size_t)(b * 2 + 0) * NCH + cf) * 1024 + 2 * pp; *(float2*)(SA + so) = make_float2(s0, s1); *(float2*)(SH + so) = make_float2(h0, h1);
    s0 = s1 = h0 = h1 = 0.f;
#pragma unroll 8
    for (int i = 31; i >= 0; --i) { const size_t o = (size_t)(row0 + i) * 2048 + 1024 + 2 * pp; const unsigned lw = *(const unsigned*)(LA + o), bw = *(const unsigned*)(BX + o);
      const float l0 = bf_lo(lw), l1 = bf_hi(lw); s0 += l0; s1 += l1; h0 = __expf(l0) * h0 + bf_lo(bw); h1 = __expf(l1) * h1 + bf_hi(bw); }
    so = ((size_t)(b * 2 + 1) * NCH + cb) * 1024 + 2 * pp; *(float2*)(SA + so) = make_float2(s0, s1); *(float2*)(SH + so) = make_float2(h0, h1);
  }
}
__device__ __forceinline__ void scan_carry_seq(const float* __restrict__ SA, const float* __restrict__ SH, float* __restrict__ CR) {
  float carry = 0.f;
#pragma unroll 1
  for (int c0 = 0; c0 < NCH; c0 += 24) {
    float a[24], h[24];
#pragma unroll
    for (int j = 0; j < 24; ++j) { a[j] = SA[(size_t)(c0 + j) * 1024]; h[j] = SH[(size_t)(c0 + j) * 1024]; }
#pragma unroll
    for (int j = 0; j < 24; ++j) { CR[(size_t)(c0 + j) * 1024] = carry; carry = __expf(a[j]) * carry + h[j]; }
  }
}
__device__ __forceinline__ void phase_scan_carry(const P& p, int wvid) {
  const size_t gtid = (size_t)blockIdx.x * 512 + tid_fresh(wvid);
  const int t = (int)(gtid & 511), wg = (int)(gtid >> 9);
  if (t >= 32) return;
  const int seq = wg * 32 + t; if (seq >= NB * 2 * 1024) return;
  const int ch = seq & 1023, bd = seq >> 10; const size_t o = (size_t)bd * NCH * 1024 + ch;
  scan_carry_seq((const float*)(p.ws + OFF_SA) + o, (const float*)(p.ws + OFF_SH) + o, (float*)(p.ws + OFF_CARRY) + o);
}
__device__ __forceinline__ void scan_fwd_item(const bf16_t* __restrict__ lp, const bf16_t* __restrict__ bp, float2* __restrict__ hfl, float h0, float h1) {
#pragma unroll
  for (int i0 = 0; i0 < 32; i0 += 8) { unsigned lw[8], bw[8];
#pragma unroll
    for (int j = 0; j < 8; ++j) { lw[j] = *(const unsigned*)(lp + (size_t)(i0 + j) * 2048); bw[j] = *(const unsigned*)(bp + (size_t)(i0 + j) * 2048); }
#pragma unroll
    for (int j = 0; j < 8; ++j) { h0 = __expf(bf_lo(lw[j])) * h0 + bf_lo(bw[j]); h1 = __expf(bf_hi(lw[j])) * h1 + bf_hi(bw[j]); hfl[(i0 + j) * 512] = make_float2(h0, h1); } }
}
__device__ __forceinline__ void scan_bwd_item(const bf16_t* __restrict__ lp, const bf16_t* __restrict__ bp, const bf16_t* __restrict__ gp, bf16_t* __restrict__ op, const float2* __restrict__ hfl, float h0, float h1) {
#pragma unroll
  for (int i0 = 24; i0 >= 0; i0 -= 8) { unsigned lw[8], bw[8], gw[8], ow[8];
#pragma unroll
    for (int j = 0; j < 8; ++j) { const int i = i0 + 7 - j; lw[j] = *(const unsigned*)(lp + (size_t)i * 2048); bw[j] = *(const unsigned*)(bp + (size_t)i * 2048); gw[j] = *(const unsigned*)(gp + (size_t)i * 1024); }
#pragma unroll
    for (int j = 0; j < 8; ++j) { const int i = i0 + 7 - j; h0 = __expf(bf_lo(lw[j])) * h0 + bf_lo(bw[j]); h1 = __expf(bf_hi(lw[j])) * h1 + bf_hi(bw[j]);
      const float2 hf = hfl[i * 512]; ow[j] = cvt_pk_bf16(bf_lo(gw[j]) * (hf.x + h0), bf_hi(gw[j]) * (hf.y + h1)); }
#pragma unroll
    for (int j = 0; j < 8; ++j) { const int i = i0 + 7 - j; *(unsigned*)(op + (size_t)i * 2048) = ow[j]; } }
}
__device__ __forceinline__ void phase_scan_final(const P& p, float2* hfl  , bool skip_ctx, int wvid) {
  const int tf = tid_fresh(wvid);
  const size_t gtid = (size_t)blockIdx.x * 512 + tf, nth = (size_t)gridDim.x * 512;
  const bf16_t* LA = (const bf16_t*)(p.ws + OFF_A); const bf16_t* BX = (const bf16_t*)(p.ws + OFF_BX); const bf16_t* GG = (const bf16_t*)(p.ws + OFF_GG);
  const float* CR = (const float*)(p.ws + OFF_CARRY); bf16_t* M2 = (bf16_t*)(p.ws + OFF_M2);
  for (size_t it = gtid; it < (size_t)NB * NCH * 512; it += nth) {
    int b, blk, pp, row0, cf, cb; scan_item(it, b, blk, pp, row0, cf, cb);
    if (skip_ctx && blk < 8) continue;
    const float2 c0 = *(const float2*)(CR + ((size_t)(b * 2 + 0) * NCH + cf) * 1024 + 2 * pp), c1 = *(const float2*)(CR + ((size_t)(b * 2 + 1) * NCH + cb) * 1024 + 2 * pp);
    scan_fwd_item(LA + (size_t)row0 * 2048 + 2 * pp, BX + (size_t)row0 * 2048 + 2 * pp, hfl + tf, c0.x, c0.y);
    scan_bwd_item(LA + (size_t)row0 * 2048 + 1024 + 2 * pp, BX + (size_t)row0 * 2048 + 1024 + 2 * pp, GG + (size_t)row0 * 1024 + 2 * pp,
                  M2 + (size_t)row0 * 2048 + 1024 + 2 * pp, hfl + tf, c1.x, c1.y);
  }
}

#ifndef TP
#define RUN(k) 1
#else
#define RUN(k) (TP == (k))
#endif
__global__ void __launch_bounds__(512, 2) fwd_megakernel(P p_unused) {
  extern __shared__ __attribute__((aligned(16))) unsigned char shm[];
  cg::grid_group grid = cg::this_grid();
  LAS unsigned char* lds = (LAS unsigned char*)shm;
  unsigned char* ws = load_p().ws;
  const char* wsc = (const char*)ws;
#define FRESH() do { ws = load_p().ws; asm volatile("" : "+s"(ws)); wsc = (const char*)ws; } while (0)
#define FRESHL() do { FRESH(); int l_ = l; asm volatile("" : "+s"(l_)); wl = wsc + OFF_W + (size_t)l_ * W_LAYER; } while (0)

  volatile LAS unsigned* xst = (volatile LAS unsigned*)(lds + STAGE_BYTES + TL_BYTES);
  const int wvid = __builtin_amdgcn_readfirstlane((int)threadIdx.x >> 6);
  if (threadIdx.x == 0) { xst[0] = 0u; xst[1] = 0u; xst[2] = 0u; xst[3] = 0u; }
  __syncthreads();
  const XcdBarrier xb = xcd_barrier_post((unsigned*)(load_p().ws + OFF_BAR), xst, (int)threadIdx.x);
#define GSYNC() do { XcdBarrier xb_ = xb; xb_.bar = (unsigned*)(load_p().ws + OFF_BAR); xcd_barrier(xb_, tid_fresh(wvid)); } while (0)
  if (RUN(0)) prep_a(load_p(), shm, wvid);
  if (load_p().ws == nullptr) grid.sync();
  GSYNC();
  {
    FRESH();
    if (RUN(1)) {
      GemmP g2{2048, 128 * 2048, 512, 128 * 512, 256}; gemm_phase(lds, g2, SchedFoldOut{ws}, EpiStore{ws, 2048}, wvid); }
    if (RUN(2)) { const int* MODI = (const int*)(ws + OFF_MOD); float* MODF = (float*)(ws + OFF_MODF); float* ml = (float*)shm; const int tq = tid_fresh(wvid);
      for (size_t i = (size_t)blockIdx.x * 512 + tq; i < (size_t)2 * 5 * 12288; i += (size_t)gridDim.x * 512) MODF[i] = (float)MODI[i] * FXI;
      for (int i = tq; i < 5 * 4096; i += 512) ml[i] = (float)MODI[(i >> 12) * 12288 + (i & 4095)] * FXI;
      __syncthreads();
      phase_e0(load_p(), ml, wvid); }
  }
  GSYNC();
  auto layer = [&](const int l) __attribute__((always_inline)) {
    const char* wl;
    const bool lastl = (l == DEPTH - 1); const int nrow = lastl ? MLAT : MALL, nMt = nrow / 256;
    FRESHL();
    if (RUN(3)) { GemmP g{4096, 128 * 4096, 4096, 128 * 4096, 2048};
      gemm_phase(lds, g, SchedReg{nMt, 12, wsc + OFF_H, wl + W_WINT, (size_t)256 * 4096, (size_t)256 * 4096},
                 EpiG1{(bf16_t*)(ws + OFF_BX), (bf16_t*)(ws + OFF_R), (bf16_t*)(ws + OFF_GG)}, wvid);
      if (!lastl) prep_late(load_p(), shm, wvid, 48);
      if (lastl) { GemmP gs{4096, 128 * 4096, 4096, 128 * 4096, 512};
        gemm_phase(lds, gs, SchedCtxSplitR{wsc + OFF_H, wl + W_WINT}, EpiSlabR{(float*)(ws + OFF_FS)}, wvid); } }
    GSYNC();
    FRESHL();
    { if (RUN(4)) { GemmP g{2048, 128 * 2048, 512, 128 * 512, 256};
        gemm_phase(lds, g, SchedDftCh{nMt, wsc + OFF_BX, wsc + OFF_CST}, EpiDftCh{(bf16_t*)(ws + OFF_A), (bf16_t*)(ws + OFF_H) + (size_t)MLAT * D, lds + STAGE_BYTES}, wvid); }
      if (RUN(6)) phase_conv(load_p(), l, lastl, wvid); }
    GSYNC();
    FRESHL();
    { if (RUN(4)) { GemmP g{262144, 512, 512, 128 * 512, 256}; gemm_phase(lds, g, SchedF2{wsc + OFF_A, wsc + OFF_D2}, EpiF2{(bf16_t*)(ws + OFF_H), lds + STAGE_BYTES}, wvid); }
 }
    GSYNC();
    FRESHL();
    { if (RUN(7)) { GemmP g{32768, 128 * 32768, 1024, 128 * 1024, 512}; gemm_phase(lds, g, SchedF3{wsc + OFF_H, wsc + OFF_D3}, EpiF3<false>{(bf16_t*)(ws + OFF_M2), lds + STAGE_BYTES}, wvid); }
      FRESHL();
      if (RUN(8)) { GemmP gg{2048, 128 * 2048, 512, 128 * 512, 256};
      gemm_phase(lds, gg, SchedGates{wsc + OFF_U, wl + W_WGT},
                 EpiGates{(const bf16_t*)(ws + OFF_U), (bf16_t*)(ws + OFF_A), (bf16_t*)(ws + OFF_BX), load_p().lru_b + (size_t)l * 4096, (const float*)(ws + OFF_SP8) + (size_t)l * 2048}, wvid); }
      FRESHL();
      if (RUN(5) && !lastl) { GemmP gc{1024, 128 * 1024, 1024, 128 * 1024, 512}; gemm_phase(lds, gc, SchedF2c{wsc + OFF_H + (size_t)MLAT * D * 2, wsc + OFF_DC}, EpiF3<true>{(bf16_t*)(ws + OFF_M2), lds + STAGE_BYTES}, wvid); } }
    GSYNC();
    FRESHL();
    if (RUN(9)) phase_scan_sum(load_p(), wvid);
    GSYNC();
    FRESHL();
    if (RUN(10)) phase_scan_carry(load_p(), wvid);
    GSYNC();
    FRESHL();
    if (RUN(11)) phase_scan_final(load_p(), (float2*)shm, lastl, wvid);
    GSYNC();
    FRESHL();
    if (RUN(12)) { GemmP g{4096, 128 * 4096, 4096, 128 * 4096, 2048};
      gemm_phase(lds, g, SchedReg{MLAT / 256, 8, wsc + OFF_M2, wl + W_WOUTT, (size_t)256 * 4096, (size_t)256 * 4096},
                 EpiYSS{(bf16_t*)(ws + OFF_A), (float*)(ws + OFF_RSSP)}, wvid);
      if (!lastl) { GemmP gs{4096, 128 * 4096, 4096, 128 * 4096, 512};
        gemm_phase(lds, gs, SchedCtxSplit{wsc + OFF_M2, wl + W_WOUTT, (size_t)256 * 4096, (size_t)256 * 4096, (size_t)512 * 2}, EpiSlab{(float*)(ws + OFF_FS)}, wvid); } }
    GSYNC();
    FRESHL();
    if (RUN(13)) phase_res(load_p(), l, 0, nrow, !lastl, wvid); if (!lastl) phase_res_ctx(load_p(), l, 0, (float*)shm, wvid);
    GSYNC();
    FRESHL();
    if (RUN(14)) { GemmP g{4096, 128 * 4096, 4096, 128 * 4096, 2048};
      gemm_phase(lds, g, SchedReg{nMt, 44, wsc + OFF_H, wl + W_WFFI, (size_t)256 * 4096, (size_t)256 * 4096}, EpiSwiGLU{(bf16_t*)(ws + OFF_ACT)}, wvid); }
    GSYNC();
    FRESHL();
    if (RUN(15)) { GemmP g{11264, 128 * 11264, 11264, 128 * 11264, DFF};
      gemm_phase(lds, g, SchedReg{MLAT / 256, 8, wsc + OFF_ACT, wl + W_WFFO, (size_t)256 * 11264, (size_t)256 * 11264},
                 EpiYSS{(bf16_t*)(ws + OFF_M2), (float*)(ws + OFF_RSSP)}, wvid);
      if (!lastl) { GemmP gs{11264, 128 * 11264, 11264, 128 * 11264, 1408};
        gemm_phase(lds, gs, SchedCtxSplit{wsc + OFF_ACT, wl + W_WFFO, (size_t)256 * 11264, (size_t)256 * 11264, (size_t)1408 * 2}, EpiSlab{(float*)(ws + OFF_FS)}, wvid); } }
    GSYNC();
    FRESHL();
    if (RUN(16)) phase_res(load_p(), l, 1, nrow, !lastl, wvid); if (!lastl) phase_res_ctx(load_p(), l, 1, (float*)shm, wvid);
    GSYNC();
  };
  layer(0);
  layer(1);
}

extern "C" void kernel_launch(void* const* d_in, const int* in_sizes, int n_in, void* d_out, int out_size,
                              void* d_ws, size_t ws_size, hipStream_t stream) {
  constexpr int LDS_BYTES = STAGE_BYTES + TL_BYTES + 16;
  static int grid = 0;
  if (!grid) {
    int dev = 0, cus = 0, per_cu = 0;
    (void)hipGetDevice(&dev);
    (void)hipDeviceGetAttribute(&cus, hipDeviceAttributeMultiprocessorCount, dev);
    (void)hipFuncSetAttribute((const void*)fwd_megakernel, hipFuncAttributeMaxDynamicSharedMemorySize, LDS_BYTES);
    (void)hipOccupancyMaxActiveBlocksPerMultiprocessor(&per_cu, (const void*)fwd_megakernel, 512, LDS_BYTES);
    grid = 256;
    fprintf(stderr, "cus %d per_cu %d grid %d ws_need %zu ws_have %zu\n", cus, per_cu, grid, (size_t)WS_END, ws_size);
  }
  if (ws_size < WS_END || n_in != 17) { fprintf(stderr, "kernel_launch: workspace too small or wrong inputs\n"); return; }
  (void)hipMemsetAsync(d_ws, 0, ZERO_BYTES, stream);
  P p{};
  p.x = (const float*)d_in[0]; p.c = (const float*)d_in[1]; p.ctx = (const float*)d_in[2]; p.c_ctx = (const float*)d_in[3];
  p.w_ada = (const float*)d_in[4]; p.b_ada = (const float*)d_in[5]; p.norm_g = (const float*)d_in[6]; p.w_in = (const float*)d_in[7];
  p.w_four = (const float*)d_in[8]; p.conv_w = (const float*)d_in[9]; p.conv_b = (const float*)d_in[10]; p.lru_w = (const float*)d_in[11];
  p.lru_b = (const float*)d_in[12]; p.lru_lam = (const float*)d_in[13]; p.w_out = (const float*)d_in[14]; p.w_ffn_in = (const float*)d_in[15];
  p.w_ffn_out = (const float*)d_in[16]; p.out = (float*)d_out; p.ws = (unsigned char*)d_ws;
  void* args[] = {&p};
  hipError_t e = hipLaunchCooperativeKernel((const void*)fwd_megakernel, dim3(grid), dim3(512), args, LDS_BYTES, stream);
  if (e != hipSuccess) fprintf(stderr, "cooperative launch failed: %s (grid %d)\n", hipGetErrorString(e), grid);
}
```
